# Optimizing an MI355X kernel written in HIP

```python
import jax, jax.numpy as jnp
from jax import lax
import numpy as np

D_MODEL = 2048
BATCH = 2
SEQ = 4096
DEPTH = 1
DEC_BATCH = 8
DEC_SEQ = 4
PAST_LEN = 16384
PAGE_SIZE = 128

A_HEADS = 8
A_KV_HEADS = 4
A_HEAD_DIM = 128
A_WIDTH = A_HEADS * A_HEAD_DIM
A_KV_WIDTH = A_KV_HEADS * A_HEAD_DIM
IDX_HEADS = 16
IDX_DIM = 64
TOPK_MAX = 256
Q_BLOCK = 128
ROPE_THETA = 10000.0
CHUNK = 128
B_GROUPS = 8
B_GROUP_DIM = 128
B_WIDTH = B_GROUPS * B_GROUP_DIM
N_MEM = 256
M_HEADS = 4
M_HEAD_DIM = 256
M_WIDTH = M_HEADS * M_HEAD_DIM
EPS = 1e-6

SPLIT_SIZES = (A_WIDTH, A_KV_WIDTH, A_KV_WIDTH, IDX_HEADS * IDX_DIM, IDX_DIM, IDX_HEADS, A_WIDTH,
               B_WIDTH, B_WIDTH, B_WIDTH,
               M_WIDTH, M_WIDTH,
               D_MODEL, D_MODEL, D_MODEL)
D_IN = sum(SPLIT_SIZES)

kernel_name = "hybrid_dsa_chunkmlp_memxattn_step"


def _rmsnorm(x, g):
    x32 = x.astype(jnp.float32)
    y = x32 * lax.rsqrt(jnp.mean(x32 * x32, axis=-1, keepdims=True) + EPS)
    return y.astype(x.dtype) * g


def _rope(x, pos):
    half = x.shape[-1] // 2
    freq = ROPE_THETA ** (-jnp.arange(half, dtype=jnp.float32) / half)
    ang = pos.astype(jnp.float32)[:, None] * freq[None, :]
    cos = jnp.cos(ang)[None, :, None, :]
    sin = jnp.sin(ang)[None, :, None, :]
    x32 = x.astype(jnp.float32)
    x1, x2 = x32[..., :half], x32[..., half:]
    return jnp.concatenate([x1 * cos - x2 * sin, x2 * cos + x1 * sin], axis=-1).astype(x.dtype)


def _project(x, g_pre, w_in):
    z = _rmsnorm(x, g_pre) @ w_in
    return jnp.split(z, list(np.cumsum(SPLIT_SIZES)[:-1]), axis=-1)


def _prep_a(q, k, v, qi, ki, wi, pos, g_q, g_k):
    Bn, T = q.shape[:2]
    q = _rope(_rmsnorm(q.reshape(Bn, T, A_HEADS, A_HEAD_DIM), g_q), pos)
    k = _rope(_rmsnorm(k.reshape(Bn, T, A_KV_HEADS, A_HEAD_DIM), g_k), pos)
    v = v.reshape(Bn, T, A_KV_HEADS, A_HEAD_DIM)
    qi = _rope(qi.reshape(Bn, T, IDX_HEADS, IDX_DIM), pos)
    ki = _rope(ki[:, :, None, :], pos)[:, :, 0, :]
    wi = wi * (IDX_HEADS ** -0.5)
    return q, k, v, qi, ki, wi


def _index_scores(qi, ki, wi):
    dots = jnp.einsum('bthd,bsd->bths', qi, ki).astype(jnp.float32) * (IDX_DIM ** -0.5)
    return jnp.einsum('bths,bth->bts', jax.nn.relu(dots), wi.astype(jnp.float32))


def _sparse_attend(q, kg, vg, valid):
    Bn, T = q.shape[:2]
    qg = q.reshape(Bn, T, A_KV_HEADS, A_HEADS // A_KV_HEADS, A_HEAD_DIM)
    s = jnp.einsum('btgrd,btkgd->btgrk', qg, kg).astype(jnp.float32) * (A_HEAD_DIM ** -0.5)
    s = jnp.where(valid[:, :, None, None, :], s, -jnp.inf)
    p = jax.nn.softmax(s, axis=-1).astype(vg.dtype)
    o = jnp.einsum('btgrk,btkgd->btgrd', p, vg)
    return o.reshape(Bn, T, A_WIDTH)


_gather_rows = jax.vmap(lambda rows, idx: rows[idx])


def _dsa_prompt(q, k, v, qi, ki, wi, topk):
    Bn, T = q.shape[:2]
    key_pos = jnp.arange(T)

    def block(i):
        start = i * Q_BLOCK
        qb = lax.dynamic_slice_in_dim(q, start, Q_BLOCK, axis=1)
        qib = lax.dynamic_slice_in_dim(qi, start, Q_BLOCK, axis=1)
        wib = lax.dynamic_slice_in_dim(wi, start, Q_BLOCK, axis=1)
        pos = start + jnp.arange(Q_BLOCK)
        sc = _index_scores(qib, ki, wib)
        sc = jnp.where((key_pos[None, :] <= pos[:, None])[None], sc, -jnp.inf)
        _, idx = lax.top_k(sc, topk)
        valid = idx <= pos[None, :, None]
        return _sparse_attend(qb, _gather_rows(k, idx), _gather_rows(v, idx), valid)

    out = lax.map(block, jnp.arange(T // Q_BLOCK))
    return out.transpose(1, 0, 2, 3).reshape(Bn, T, A_WIDTH)


def _dsa_sample(q, k_new, v_new, qi, ki_new, wi, cache_k, cache_v, cache_kidx, page_table, topk):
    Bn, T = q.shape[:2]
    n_past = page_table.shape[1] * PAGE_SIZE
    ki_past = cache_kidx[page_table].reshape(Bn, n_past, IDX_DIM)
    ki_all = jnp.concatenate([ki_past, ki_new], axis=1)
    L = n_past + T
    pos = n_past + jnp.arange(T)
    sc = _index_scores(qi, ki_all, wi)
    sc = jnp.where((jnp.arange(L)[None, :] <= pos[:, None])[None], sc, -jnp.inf)
    _, idx = lax.top_k(sc, topk)
    valid = idx <= pos[None, :, None]
    in_past = idx < n_past
    pidx = jnp.minimum(idx, n_past - 1)
    phys = _gather_rows(page_table, pidx // PAGE_SIZE)
    off = pidx % PAGE_SIZE
    nidx = jnp.clip(idx - n_past, 0, T - 1)
    sel = in_past[..., None, None]
    kg = jnp.where(sel, cache_k[phys, off], _gather_rows(k_new, nidx))
    vg = jnp.where(sel, cache_v[phys, off], _gather_rows(v_new, nidx))
    return _sparse_attend(q, kg, vg, valid)


def _chunk_mix(u, v, g_sgu, w_s, b_s):
    Bn, T, _ = v.shape
    vn = _rmsnorm(v, g_sgu).reshape(Bn, T, B_GROUPS, B_GROUP_DIM)
    n_chunks = -(-T // CHUNK)
    vp = jnp.pad(vn, ((0, 0), (0, n_chunks * CHUNK - T), (0, 0), (0, 0)))
    vp = vp.reshape(Bn, n_chunks, CHUNK, B_GROUPS, B_GROUP_DIM)
    tril = jnp.tril(jnp.ones((CHUNK, CHUNK), dtype=bool))
    ws = jnp.where(tril[None], w_s, 0)
    s = jnp.einsum('gpq,bnqgc->bnpgc', ws, vp) + b_s.T[None, None, :, :, None]
    s = s.reshape(Bn, n_chunks * CHUNK, B_WIDTH)[:, :T]
    return u * s, vn


def _mem_kv(mem, g_mem, w_mem_kv, g_mk):
    Bn, M, _ = mem.shape
    k, v = jnp.split(_rmsnorm(mem, g_mem) @ w_mem_kv, 2, axis=-1)
    k = _rmsnorm(k.reshape(Bn, M, M_HEADS, M_HEAD_DIM), g_mk)
    return k, v.reshape(Bn, M, M_HEADS, M_HEAD_DIM)


def _mem_attend(q, g_mq, mk, mv):
    Bn, T = q.shape[:2]
    q = _rmsnorm(q.reshape(Bn, T, M_HEADS, M_HEAD_DIM), g_mq)
    s = jnp.einsum('bthd,bmhd->bhtm', q, mk).astype(jnp.float32) * (M_HEAD_DIM ** -0.5)
    p = jax.nn.softmax(s, axis=-1).astype(mv.dtype)
    return jnp.einsum('bhtm,bmhd->bthd', p, mv).reshape(Bn, T, M_WIDTH)


def _merge(x, oa, ga, ob, gb, oc, gc, ra, rb, rc, w_pa, w_pb, w_pc, w_out):
    m = (jax.nn.sigmoid(ra) * ((oa * jax.nn.silu(ga)) @ w_pa)
         + jax.nn.sigmoid(rb) * ((ob * jax.nn.silu(gb)) @ w_pb)
         + jax.nn.sigmoid(rc) * ((oc * jax.nn.silu(gc)) @ w_pc))
    return x + m @ w_out


def setup_inputs(seed: int = 0) -> dict:
    key = jax.random.key(seed)
    ks = jax.random.split(key, 26)
    n_pages = PAST_LEN // PAGE_SIZE
    n_used = DEC_BATCH * n_pages
    n_pool = n_used + max(1, n_used // 4)
    nrm = lambda k, shape, s=1.0: jax.random.normal(k, shape, jnp.float32) * s
    gain = lambda k, n: 1.0 + 0.01 * jax.random.normal(k, (n,), jnp.float32)
    page_table = jax.random.permutation(ks[0], n_pool)[:n_used].reshape(DEC_BATCH, n_pages).astype(jnp.int32)
    return {
        "x_prompt": nrm(ks[1], (BATCH, SEQ, D_MODEL)),
        "x_sample": nrm(ks[2], (DEC_BATCH, DEC_SEQ, D_MODEL)),
        "cache_k": nrm(ks[3], (n_pool, PAGE_SIZE, A_KV_HEADS, A_HEAD_DIM)),
        "cache_v": nrm(ks[4], (n_pool, PAGE_SIZE, A_KV_HEADS, A_HEAD_DIM)),
        "cache_kidx": nrm(ks[5], (n_pool, PAGE_SIZE, IDX_DIM)),
        "cache_mem_k": nrm(ks[6], (DEC_BATCH, N_MEM, M_HEADS, M_HEAD_DIM)),
        "cache_mem_v": nrm(ks[7], (DEC_BATCH, N_MEM, M_HEADS, M_HEAD_DIM)),
        "page_table": page_table,
        "mem_prompt": nrm(ks[8], (BATCH, N_MEM, D_MODEL)),
        "g_pre": gain(ks[9], D_MODEL),
        "w_in": nrm(ks[10], (D_MODEL, D_IN), D_MODEL ** -0.5),
        "g_q": gain(ks[11], A_HEAD_DIM),
        "g_k": gain(ks[12], A_HEAD_DIM),
        "g_mq": gain(ks[13], M_HEAD_DIM),
        "g_mk": gain(ks[14], M_HEAD_DIM),
        "g_mem": gain(ks[15], D_MODEL),
        "w_mem_kv": nrm(ks[16], (D_MODEL, 2 * M_WIDTH), D_MODEL ** -0.5),
        "g_sgu": gain(ks[17], B_WIDTH),
        "w_s": nrm(ks[18], (B_GROUPS, CHUNK, CHUNK), CHUNK ** -0.5),
        "b_s": 1.0 + 0.02 * jax.random.normal(ks[19], (B_GROUPS, CHUNK), jnp.float32),
        "w_pa": nrm(ks[20], (A_WIDTH, D_MODEL), A_WIDTH ** -0.5),
        "w_pb": nrm(ks[21], (B_WIDTH, D_MODEL), B_WIDTH ** -0.5),
        "w_pc": nrm(ks[22], (M_WIDTH, D_MODEL), M_WIDTH ** -0.5),
        "w_out": nrm(ks[23], (D_MODEL, D_MODEL), D_MODEL ** -0.5),
    }


def reference(x_prompt, x_sample, cache_k, cache_v, cache_kidx, cache_mem_k, cache_mem_v, page_table,
              mem_prompt, g_pre, w_in, g_q, g_k, g_mq, g_mk, g_mem, w_mem_kv, g_sgu, w_s, b_s,
              w_pa, w_pb, w_pc, w_out):
    T = x_prompt.shape[1]
    y_prompt = x_prompt
    for _ in range(DEPTH):
        (aq, ak, av, aqi, aki, awi, ag, bu, bv, bg, cq, cg, ra, rb, rc) = _project(y_prompt, g_pre, w_in)
        q, k_p, v_p, qi, ki_p, wi = _prep_a(aq, ak, av, aqi, aki, awi, jnp.arange(T), g_q, g_k)
        oa = _dsa_prompt(q, k_p, v_p, qi, ki_p, wi, min(TOPK_MAX, T // 4))
        ob, _ = _chunk_mix(bu, bv, g_sgu, w_s, b_s)
        mk_p, mv_p = _mem_kv(mem_prompt, g_mem, w_mem_kv, g_mk)
        oc = _mem_attend(cq, g_mq, mk_p, mv_p)
        y_prompt = _merge(y_prompt, oa, ag, ob, bg, oc, cg, ra, rb, rc, w_pa, w_pb, w_pc, w_out)

    Ts = x_sample.shape[1]
    n_past = page_table.shape[1] * PAGE_SIZE
    y_sample = x_sample
    for _ in range(DEPTH):
        (aq, ak, av, aqi, aki, awi, ag, bu, bv, bg, cq, cg, ra, rb, rc) = _project(y_sample, g_pre, w_in)
        q, k_s, v_s, qi, ki_s, wi = _prep_a(aq, ak, av, aqi, aki, awi, n_past + jnp.arange(Ts), g_q, g_k)
        oa = _dsa_sample(q, k_s, v_s, qi, ki_s, wi, cache_k, cache_v, cache_kidx, page_table,
                         min(TOPK_MAX, (n_past + Ts) // 4))
        ob, chunk_v_s = _chunk_mix(bu, bv, g_sgu, w_s, b_s)
        oc = _mem_attend(cq, g_mq, cache_mem_k, cache_mem_v)
        y_sample = _merge(y_sample, oa, ag, ob, bg, oc, cg, ra, rb, rc, w_pa, w_pb, w_pc, w_out)

    return (y_prompt, y_sample, k_p, v_p, ki_p, mk_p, mv_p, k_s, v_s, ki_s, chunk_v_s)
```

```cpp
#include <hip/hip_runtime.h>
#include <cstdio>
#include <cstdint>
#include <cmath>

namespace pg8 {
#define PG8_LAS __attribute__((address_space(3)))
typedef unsigned short bf16_t;
typedef short bf16x8 __attribute__((ext_vector_type(8)));
typedef float f32x4 __attribute__((ext_vector_type(4)));
typedef unsigned u32x4 __attribute__((ext_vector_type(4)));
constexpr int BM = 256, BK = 64, HALF = 128, HTB = HALF * BK * 2  , STAGE_BYTES = 8 * HTB, NXCD = 8, WGM = 8;

__host__ __device__ __forceinline__ int lds_byte(int r, int c) { const int st = (r >> 4) * 2 + (c >> 5), rr = r & 15, cc = c & 31, ob = rr * 64 + cc * 2; return st * 1024 + (ob ^ (((ob >> 9) & 1) << 5)); }
__host__ __device__ __forceinline__ void stage_rc(int b, int& R, int& C) { const int st = b / 1024, sb = b % 1024, swz = sb ^ (((sb >> 9) & 1) << 5); R = (st >> 1) * 16 + swz / 64; C = (st & 1) * 32 + (swz % 64) / 2; }
__host__ __device__ __forceinline__ int perm32(int rho) { const int n = rho >> 4, i = rho & 15; return 8 * (i >> 2) + 4 * n + (i & 3); }

struct Unit { int pm, pn; };
struct Gemm { const bf16_t* A; const bf16_t* Bt; int M, N, K; };

__device__ __forceinline__ unsigned cvt_pk_bf16(float lo, float hi) { unsigned r; asm volatile("v_cvt_pk_bf16_f32 %0, %1, %2" : "=v"(r) : "v"(lo), "v"(hi)); return r; }
typedef float f32x2 __attribute__((ext_vector_type(2)));
template <class Epi, class Sched, bool ALIGN_EPI = false, bool SP2 = false>
__device__ __forceinline__ void gemm_phase(PG8_LAS unsigned char* lds, const Gemm g, const Sched& S, const Epi& E) {
    const int tid = threadIdx.x, wid = __builtin_amdgcn_readfirstlane(tid >> 6), lane = tid & 63, wr = wid >> 2, wc = wid & 3, fr = lane & 15, fq = lane >> 4;
    const int K = g.K, nt = K / BK;
    unsigned voffA[2], voffB[2];
#pragma unroll
    for (int i = 0; i < 2; ++i) { int R, C; stage_rc(tid * 16 + i * 8192, R, C); const int Rb = Epi::PERM ? ((R & ~31) + perm32(R & 31)) : R;
        voffA[i] = (unsigned)(R * K + C) * 2u; voffB[i] = (unsigned)(Rb * K + C) * 2u; }
    const size_t kstep = (size_t)(BK * 2);
    const size_t hstep = (size_t)HALF * K * 2;
    const size_t tstep = 2 * hstep;
    const unsigned ldsw = (unsigned)wid * 1024u;
    const int aoff = lds_byte(wr * 64 + fr, fq * 8), boff = lds_byte(wc * 32 + fr, fq * 8);
#define PG8_SA(b, h) (((b) * 2 + (h)) * HTB)
#define PG8_SB(b, h) ((4 + (b) * 2 + (h)) * HTB)
#define PG8_STAGE(bufoff, gbase, voff) do { _Pragma("unroll") for (int _i = 0; _i < 2; ++_i) \
        __builtin_amdgcn_global_load_lds((const unsigned*)((const char*)(gbase) + (voff)[_i]), (PG8_LAS unsigned*)(lds + (bufoff) + ldsw + _i * 8192), 16, 0, 0); } while (0)
#define PG8_LDA(dst, b, h) do { _Pragma("unroll") for (int m = 0; m < 4; ++m) _Pragma("unroll") for (int k = 0; k < 2; ++k) dst[m][k] = *(const PG8_LAS bf16x8*)(lds + PG8_SA(b, h) + aoff + m * 2048 + k * 1024); } while (0)
#define PG8_LDB(dst, b, h) do { _Pragma("unroll") for (int n = 0; n < 2; ++n) _Pragma("unroll") for (int k = 0; k < 2; ++k) dst[n][k] = *(const PG8_LAS bf16x8*)(lds + PG8_SB(b, h) + boff + n * 2048 + k * 1024); } while (0)
#define PG8_MMA(ai, bj, At, Bt) do { __builtin_amdgcn_s_setprio(1); _Pragma("unroll") for (int m = 0; m < 4; ++m) _Pragma("unroll") for (int n = 0; n < 2; ++n) _Pragma("unroll") for (int k = 0; k < 2; ++k) \
        acc[ai][bj][m][n] = __builtin_amdgcn_mfma_f32_16x16x32_bf16(Bt[n][k], At[m][k], acc[ai][bj][m][n], 0, 0, 0); __builtin_amdgcn_s_setprio(0); } while (0)
#define PG8_WAIT_V(n) asm volatile("s_waitcnt vmcnt(" #n ")" ::: "memory")
#define PG8_WAIT_L(n) asm volatile("s_waitcnt lgkmcnt(" #n ")" ::: "memory")
#define PG8_BAR __builtin_amdgcn_s_barrier()
#define PG8_SCHED __builtin_amdgcn_sched_barrier(0)
    Unit cur, nxt; int ui = 0;
    if (!S.next(0, cur)) return;
    f32x4 acc[2][2][4][2];
#pragma unroll
    for (int a = 0; a < 2; ++a)
#pragma unroll
        for (int b = 0; b < 2; ++b)
#pragma unroll
            for (int m = 0; m < 4; ++m)
#pragma unroll
                for (int n = 0; n < 2; ++n) acc[a][b][m][n] = (f32x4){0.f, 0.f, 0.f, 0.f};
    bf16x8 At[4][2], B0[2][2], B1[2][2];
    const char* cA = (const char*)g.A + (size_t)cur.pm * tstep; const char* cB = (const char*)g.Bt + (size_t)cur.pn * tstep;
    S.a_ready(cur);
    if constexpr (SP2) {
        PG8_STAGE(PG8_SB(0, 0), cB, voffB); PG8_STAGE(PG8_SB(0, 1), cB + hstep, voffB); PG8_STAGE(PG8_SA(0, 0), cA, voffA); PG8_STAGE(PG8_SA(0, 1), cA + hstep, voffA);
        if (wr == 1) PG8_BAR;
        PG8_WAIT_V(2); PG8_BAR;
        PG8_STAGE(PG8_SB(1, 0), cB + kstep, voffB); PG8_STAGE(PG8_SA(1, 0), cA + kstep, voffA); PG8_STAGE(PG8_SB(1, 1), cB + hstep + kstep, voffB);
        PG8_WAIT_V(6); PG8_BAR;
    } else {
        PG8_STAGE(PG8_SB(0, 0), cB, voffB); PG8_STAGE(PG8_SA(0, 0), cA, voffA); PG8_STAGE(PG8_SB(0, 1), cB + hstep, voffB); PG8_STAGE(PG8_SA(0, 1), cA + hstep, voffA);
        if (wr == 1) PG8_BAR;
        PG8_WAIT_V(4); PG8_BAR;
        PG8_STAGE(PG8_SB(1, 0), cB + kstep, voffB); PG8_STAGE(PG8_SA(1, 0), cA + kstep, voffA); PG8_STAGE(PG8_SB(1, 1), cB + hstep + kstep, voffB);
        PG8_WAIT_V(6); PG8_BAR;
    }
    for (;;) {
        const bool has_next = S.next(ui + 1, nxt);
        const char* nA = has_next ? (const char*)g.A + (size_t)nxt.pm * tstep : cA; const char* nB = has_next ? (const char*)g.Bt + (size_t)nxt.pn * tstep : cB;
        for (int t = 0; t < nt; t += 2) {
            const bool last = (t == nt - 2);
            const char* a1 = cA + (size_t)(t + 1) * kstep;
            const char* a2 = last ? nA : cA + (size_t)(t + 2) * kstep; const char* b2 = last ? nB : cB + (size_t)(t + 2) * kstep;
            const char* a3 = a2 + kstep; const char* b3 = b2 + kstep;
            if (last && has_next) S.a_ready(nxt);
            if constexpr (SP2) {
            PG8_LDB(B0, 0, 0); PG8_LDB(B1, 0, 1); PG8_SCHED; PG8_LDA(At, 0, 0); PG8_STAGE(PG8_SA(1, 1), a1 + hstep, voffA);
            PG8_WAIT_V(8); PG8_WAIT_L(0); PG8_BAR; PG8_MMA(0, 0, At, B0); PG8_MMA(0, 1, At, B1); PG8_BAR; PG8_SCHED;
            PG8_LDA(At, 0, 1); PG8_STAGE(PG8_SB(0, 0), b2, voffB); PG8_STAGE(PG8_SB(0, 1), b2 + hstep, voffB); PG8_STAGE(PG8_SA(0, 0), a2, voffA);
            PG8_WAIT_V(8); PG8_WAIT_L(0); PG8_BAR; PG8_MMA(1, 0, At, B0); PG8_MMA(1, 1, At, B1); PG8_BAR; PG8_SCHED;
            PG8_LDB(B0, 1, 0); PG8_LDB(B1, 1, 1); PG8_SCHED; PG8_LDA(At, 1, 0); PG8_STAGE(PG8_SA(0, 1), a2 + hstep, voffA);
            PG8_WAIT_V(8); PG8_WAIT_L(0); PG8_BAR; PG8_MMA(0, 0, At, B0); PG8_MMA(0, 1, At, B1); PG8_BAR; PG8_SCHED;
            PG8_LDA(At, 1, 1); PG8_STAGE(PG8_SB(1, 0), b3, voffB); PG8_STAGE(PG8_SB(1, 1), b3 + hstep, voffB); PG8_STAGE(PG8_SA(1, 0), a3, voffA);
            PG8_WAIT_V(8); PG8_WAIT_L(0); PG8_BAR; PG8_MMA(1, 0, At, B0); PG8_MMA(1, 1, At, B1); PG8_BAR; PG8_SCHED;
            } else {
            PG8_LDB(B0, 0, 0); PG8_SCHED; PG8_LDA(At, 0, 0); PG8_STAGE(PG8_SA(1, 1), a1 + hstep, voffA);
            PG8_WAIT_L(8); PG8_BAR; PG8_WAIT_L(0); PG8_MMA(0, 0, At, B0); PG8_BAR; PG8_SCHED;
            PG8_LDB(B1, 0, 1); PG8_STAGE(PG8_SB(0, 0), b2, voffB);
            PG8_BAR; PG8_WAIT_L(0); PG8_MMA(0, 1, At, B1); PG8_BAR;
            PG8_LDA(At, 0, 1); PG8_STAGE(PG8_SA(0, 0), a2, voffA);
            PG8_BAR; PG8_WAIT_L(0); PG8_MMA(1, 0, At, B0); PG8_BAR; PG8_SCHED;
            PG8_STAGE(PG8_SB(0, 1), b2 + hstep, voffB);
            PG8_WAIT_V(6); PG8_BAR; PG8_MMA(1, 1, At, B1); PG8_BAR;
            PG8_LDB(B0, 1, 0); PG8_SCHED; PG8_LDA(At, 1, 0); PG8_STAGE(PG8_SA(0, 1), a2 + hstep, voffA);
            PG8_WAIT_L(8); PG8_BAR; PG8_WAIT_L(0); PG8_MMA(0, 0, At, B0); PG8_BAR; PG8_SCHED;
            PG8_LDB(B1, 1, 1); PG8_STAGE(PG8_SB(1, 0), b3, voffB);
            PG8_BAR; PG8_WAIT_L(0); PG8_MMA(0, 1, At, B1); PG8_BAR;
            PG8_LDA(At, 1, 1); PG8_STAGE(PG8_SA(1, 0), a3, voffA);
            PG8_BAR; PG8_WAIT_L(0); PG8_MMA(1, 0, At, B0); PG8_BAR; PG8_SCHED;
            PG8_STAGE(PG8_SB(1, 1), b3 + hstep, voffB);
            PG8_WAIT_V(6); PG8_BAR; PG8_MMA(1, 1, At, B1); PG8_BAR;
            }
        }
        if constexpr (ALIGN_EPI) { if (wr == 0) PG8_BAR; }
        if constexpr (!Epi::AFTER_DRAIN) { E(acc, cur, wr, wc, fr, fq); S.done(cur); }
        if (!has_next) break;
#pragma unroll
        for (int a = 0; a < 2; ++a)
#pragma unroll
            for (int b = 0; b < 2; ++b)
#pragma unroll
                for (int m = 0; m < 4; ++m)
#pragma unroll
                    for (int n = 0; n < 2; ++n) acc[a][b][m][n] = (f32x4){0.f, 0.f, 0.f, 0.f};
        cur = nxt; cA = nA; cB = nB; ++ui;
        if constexpr (ALIGN_EPI) { if (wr == 1) PG8_BAR; }
    }
    PG8_WAIT_V(0);
    if constexpr (!ALIGN_EPI) { if (wr == 0) PG8_BAR; }
    PG8_BAR;
    if constexpr (Epi::AFTER_DRAIN) { E.fused(acc, cur, wr, wc, fr, fq, lds, wid, lane); S.done(cur); }
#undef PG8_SA
#undef PG8_SB
#undef PG8_STAGE
#undef PG8_LDA
#undef PG8_LDB
#undef PG8_MMA
#undef PG8_WAIT_V
#undef PG8_WAIT_L
#undef PG8_BAR
#undef PG8_SCHED
}
}

constexpr int DM = 2048, TP = 8192, SEQ = 4096, TS = 32, PAST = 16384;
constexpr int ROWS_T = 8448;
constexpr int ROWS_A = 8960;
constexpr int D_IN = 15440, NPAD = 15616;
constexpr int NB_ALL = NPAD + 2048;
constexpr int TOPK = 256;
constexpr float EPS = 1e-6f;
constexpr float LOG2E = 1.4426950408889634f;
constexpr float QS_A = 0.08838834764831845f * LOG2E;
constexpr float QS_C = 0.0625f * LOG2E;

constexpr size_t O_YP = 0, O_YS = 16777216, O_KP = 16842752, O_VP = 21037056, O_KIP = 25231360, O_MKP = 25755648, O_MVP = 26279936,
                 O_KS = 26804224, O_VS = 26820608, O_KIS = 26836992, O_CVS = 26839040, O_TOTAL = 26871808;

constexpr size_t MiB = 1u << 20;
constexpr size_t WS_CTL = 0, CTL_ZERO_BYTES = 1 * MiB;
constexpr size_t WS_WIN = 2 * MiB;
constexpr size_t WS_WP = 72 * MiB;
constexpr size_t WS_WOUT = 84 * MiB;
constexpr size_t WS_WST = 92 * MiB;
constexpr size_t WS_CS = 93 * MiB;
constexpr size_t WS_XN = 97 * MiB;
constexpr size_t WS_QB = 132 * MiB;
constexpr size_t WS_KB = 149 * MiB;
constexpr size_t WS_VB = 158 * MiB;
constexpr size_t WS_QI = 167 * MiB;
constexpr size_t WS_KI = 184 * MiB;
constexpr size_t WS_WI = 186 * MiB;
constexpr size_t WS_SGA = 187 * MiB;
constexpr size_t WS_SGB = 204 * MiB;
constexpr size_t WS_SGC = 221 * MiB;
constexpr size_t WS_BU = 238 * MiB;
constexpr size_t WS_BV = 255 * MiB;
constexpr size_t WS_SSQ = 288 * MiB;
constexpr size_t WS_QC = 289 * MiB;
constexpr size_t WS_R = 306 * MiB;
constexpr size_t R_STRIDE = (size_t)ROWS_T * 2048;
constexpr size_t WS_MK = 405 * MiB;
constexpr size_t WS_MV = 406 * MiB;
constexpr size_t WS_MASK = 407 * MiB;
constexpr size_t WS_SS = 411 * MiB;
constexpr int SS_LD = 16512;
constexpr size_t WS_Z = 414 * MiB;
constexpr size_t Z_STRIDE = (size_t)ROWS_T * 1024;
constexpr size_t WS_M32 = 464 * MiB;
constexpr size_t WS_MB = 528 * MiB;
constexpr size_t WS_END = 562 * MiB;
static_assert(WS_WIN + (size_t)NB_ALL * 2048 * 2 <= WS_WP && WS_XN + (size_t)ROWS_A * 2048 * 2 <= WS_QB && WS_BV + (size_t)ROWS_T * 1024 * 4 <= WS_SSQ, "ws map");
static_assert(WS_R + 3 * R_STRIDE * 2 <= WS_MK && WS_Z + 3 * Z_STRIDE * 2 <= WS_M32 && WS_M32 + (size_t)TP * 2048 * 4 <= WS_MB && WS_MB + (size_t)ROWS_T * 2048 * 2 <= WS_END, "ws map 2");
static_assert(WS_CS + (size_t)4100 * 96 * 8 <= WS_XN && WS_SS + (size_t)32 * SS_LD * 4 <= WS_Z, "ws map 3");

constexpr int CW_BAR = 4096;

constexpr int RING_BYTES = 131072;
constexpr int XCH_OFF = RING_BYTES;
constexpr int LDSCTL_OFF = RING_BYTES + 16384;
constexpr int MISC_OFF = LDSCTL_OFF + 320;
constexpr int LDS_BYTES = 163840;

#define GAS __attribute__((address_space(1)))
#define LAS __attribute__((address_space(3)))
typedef unsigned short bf16;
typedef unsigned v4u __attribute__((ext_vector_type(4)));
typedef float f32x4 __attribute__((ext_vector_type(4)));
typedef short bf16x8 __attribute__((ext_vector_type(8)));
typedef GAS unsigned gu32;
typedef GAS unsigned long long gu64;
#define RLX_AGENT __ATOMIC_RELAXED, __HIP_MEMORY_SCOPE_AGENT
#define LDS_WAIT() asm volatile("s_waitcnt lgkmcnt(0)" ::: "memory")
#define VM_WAIT() asm volatile("s_waitcnt vmcnt(0)" ::: "memory")
__device__ __forceinline__ unsigned long long rt() { return __builtin_amdgcn_s_memrealtime(); }
__device__ __forceinline__ unsigned f2bf(float f) { unsigned u = __builtin_bit_cast(unsigned, f); return (u + 0x7fffu + ((u >> 16) & 1u)) >> 16; }
__device__ __forceinline__ unsigned pk2(float lo, float hi) { return f2bf(lo) | (f2bf(hi) << 16); }

#define XB_TMO      128
#define XB_XCNT(j)  (256  + 64 * (j))
#define XB_XSUB(j)  (1280 + 64 * (j))
#define XB_XGEN(j)  (2304 + 64 * (j))
#define XB_TOP      3328
#define XB_TOPGEN   3392
#define XCD_BAR_WORDS 3456
#define XB_SPIN_CAP (1u << 18)

__device__ __forceinline__ unsigned xb_ld(unsigned* p)              { return __hip_atomic_load(p, __ATOMIC_RELAXED, __HIP_MEMORY_SCOPE_AGENT); }
__device__ __forceinline__ unsigned xb_add(unsigned* p, unsigned v) { return __hip_atomic_fetch_add(p, v, __ATOMIC_RELAXED, __HIP_MEMORY_SCOPE_AGENT); }
__device__ __forceinline__ unsigned xb_xcc_id() { return (unsigned)__builtin_amdgcn_s_getreg((3 << 11) | 20) & 0xFu; }
#define XB_SPIN(cond, bar) do { unsigned _sp = 0; while (cond) { __builtin_amdgcn_s_sleep(1); \
    if ((++_sp & 255u) == 0u) { if (xb_ld(&(bar)[XB_TMO])) break; if (_sp > XB_SPIN_CAP) { atomicAdd(&(bar)[XB_TMO], 1u); break; } } } } while (0)

struct XcdBarrier {
    unsigned* bar; unsigned x;
    volatile LAS unsigned* st;
};

__device__ __forceinline__ XcdBarrier xcd_barrier_post(unsigned* bar, volatile LAS unsigned* st) {
    XcdBarrier b; b.bar = bar; b.x = xb_xcc_id(); b.st = st;
    if (threadIdx.x == 0) (void)xb_add(&bar[XB_XCNT(b.x)], 1u);
    return b;
}
__device__ __forceinline__ void xcd_barrier_complete(unsigned* bar, unsigned x, unsigned& nloc, unsigned& nx) {
    const unsigned G = gridDim.x * gridDim.y * gridDim.z;
    unsigned sum, cnt, mine, sp = 0u;
    for (;;) {
        sum = 0u; cnt = 0u; mine = 0u;
#pragma unroll
        for (unsigned j = 0; j < 16; ++j) { const unsigned c = xb_ld(&bar[XB_XCNT(j)]); sum += c; cnt += (c > 0u) ? 1u : 0u; mine = (j == x) ? c : mine; }
        if (sum == G) break;
        __builtin_amdgcn_s_sleep(1);
        if ((++sp & 255u) == 0u) { if (xb_ld(&bar[XB_TMO])) break; if (sp > XB_SPIN_CAP) { atomicAdd(&bar[XB_TMO], 1u); break; } }
    }
    nloc = mine > 0u ? mine : 1u; nx = cnt > 0u ? cnt : 1u;
}

__device__ __forceinline__ void xcd_barrier(const XcdBarrier& b) {
    asm volatile("s_waitcnt vmcnt(0)" ::: "memory");
    __syncthreads();
    if (threadIdx.x == 0) {
        unsigned* bar = b.bar;
        __builtin_amdgcn_s_waitcnt(0);
        unsigned nloc = b.st[0], nx = b.st[1];
        if (nloc == 0u) { xcd_barrier_complete(bar, b.x, nloc, nx); b.st[0] = nloc; b.st[1] = nx; }
        const unsigned old = xb_add(&bar[XB_XSUB(b.x)], 1u);
        const unsigned gen = old / nloc;
        if (old + 1u == (gen + 1u) * nloc) {
            __builtin_amdgcn_fence(__ATOMIC_RELEASE, "agent");
            asm volatile("s_waitcnt vmcnt(0)" ::: "memory");
            const unsigned og = xb_add(&bar[XB_TOP], 1u);
            const unsigned tg = og / nx;
            if (og + 1u == (tg + 1u) * nx) xb_add(&bar[XB_TOPGEN], 1u);
            else XB_SPIN(xb_ld(&bar[XB_TOPGEN]) == tg, bar);
            __builtin_amdgcn_fence(__ATOMIC_ACQUIRE, "agent");
            xb_add(&bar[XB_XGEN(b.x)], 1u);
            asm volatile("s_waitcnt vmcnt(0)" ::: "memory");
        } else {
            XB_SPIN(xb_ld(&bar[XB_XGEN(b.x)]) == gen, bar);
            __builtin_amdgcn_fence(__ATOMIC_ACQUIRE, "agent");
            asm volatile("s_waitcnt vmcnt(0)" ::: "memory");
        }
    }
    __syncthreads();
}

typedef _Float16 h8 __attribute__((ext_vector_type(8)));
typedef _Float16 h4 __attribute__((ext_vector_type(4)));
typedef _Float16 h2v __attribute__((ext_vector_type(2)));
typedef float f32x16 __attribute__((ext_vector_type(16)));
typedef float f32x2 __attribute__((ext_vector_type(2)));
typedef short s16x4 __attribute__((ext_vector_type(4)));
typedef unsigned u32x2 __attribute__((ext_vector_type(2)));
typedef __bf16 bf16x2_t __attribute__((ext_vector_type(2)));

__device__ __forceinline__ unsigned cvtpk(float lo, float hi) { f32x2 v = {lo, hi}; bf16x2_t b = __builtin_convertvector(v, bf16x2_t); return __builtin_bit_cast(unsigned, b); }
__device__ __forceinline__ unsigned cvtpk_h(float lo, float hi) { f32x2 v = {lo, hi}; h2v b = __builtin_convertvector(v, h2v); return __builtin_bit_cast(unsigned, b); }
__device__ __forceinline__ float bf2f(unsigned short h) { return __uint_as_float((unsigned)h << 16); }
__device__ __forceinline__ float sigmoidf_(float x) { return __builtin_amdgcn_rcpf(1.0f + __builtin_amdgcn_exp2f(-x * LOG2E)); }
__device__ __forceinline__ float siluf_(float x) { return x * sigmoidf_(x); }
__device__ __forceinline__ int crow(int r, int hi) { return (r & 3) + 8 * (r >> 2) + 4 * hi; }
#define BAR_LDS() do { asm volatile("s_waitcnt lgkmcnt(0)" ::: "memory"); __builtin_amdgcn_s_barrier(); asm volatile("" ::: "memory"); } while (0)

struct Ptrs {
    const float* in[24]; float* out; unsigned char* ws;
};

__device__ __forceinline__ int rope128_pos(int d) { const int s = d >> 6, dd = d & 63; return 8 * (dd >> 2) + 4 * s + (dd & 3); }
__device__ __forceinline__ int rope64_pos(int d) { const int n = d >> 5, dd = d & 31; return 32 * (dd >> 4) + 8 * ((dd >> 2) & 3) + 4 * n + (dd & 3); }
__device__ __forceinline__ int win_dst_row(int n) {
    if (n < 1024) return (n & ~127) + rope128_pos(n & 127);
    if (n < 1536) { const int j = n - 1024; return 1024 + (j & ~127) + rope128_pos(j & 127); }
    if (n < 2048) return n;
    if (n < 3072) { const int j = n - 2048; return 2048 + (j & ~63) + rope64_pos(j & 63); }
    if (n < 3136) return 15360 + rope64_pos(n - 3072);
    if (n < 3152) return 15424 + (n - 3136);
    return n - 80;
}
template <int MODE>
__device__ __forceinline__ void p0_transpose_item(const float* W, int K, int N, bf16* WT, int row_off, LAS float* scr, int item, int lane) {
    const int nblk = (N + 31) / 32, kb = item / nblk, nb = item % nblk, k0 = 64 * kb, n0 = 32 * nb;
    const int nl = n0 + (lane & 31);
#pragma unroll 8
    for (int i = 0; i < 32; ++i) { const int kk = 2 * i + (lane >> 5); scr[kk * 33 + (lane & 31)] = (nl < N) ? W[(size_t)(k0 + kk) * N + nl] : 0.f; }
    LDS_WAIT(); asm volatile("" ::: "memory");
    const int c = lane & 7;
#pragma unroll
    for (int j = 0; j < 4; ++j) { const int n = (lane >> 3) + 8 * j; const LAS float* s = scr + (8 * c) * 33 + n;
        v4u o; o.x = pk2(s[0 * 33], s[1 * 33]); o.y = pk2(s[2 * 33], s[3 * 33]); o.z = pk2(s[4 * 33], s[5 * 33]); o.w = pk2(s[6 * 33], s[7 * 33]);
        if (n0 + n < N) { const int row = MODE ? win_dst_row(n0 + n) : (row_off + n0 + n);
            *(GAS v4u*)(WT + (size_t)row * K + k0 + 8 * c) = o; } }
    LDS_WAIT(); asm volatile("" ::: "memory");
}
__device__ __forceinline__ float wave_sum(float v) {
#pragma unroll
    for (int o = 1; o < 64; o <<= 1) v += __shfl_xor(v, o);
    return v;
}
__device__ __forceinline__ void rms_row_to_bf16(const float* xrow, const float* g, bf16* orow, int lane) {
    const GAS f32x4* xr = (const GAS f32x4*)xrow + lane; const GAS f32x4* gr = (const GAS f32x4*)g + lane;
    f32x4 v[8]; float s = 0.f;
#pragma unroll
    for (int j = 0; j < 8; ++j) { v[j] = xr[64 * j]; s += (v[j].x * v[j].x + v[j].y * v[j].y) + (v[j].z * v[j].z + v[j].w * v[j].w); }
    const float rs = 1.0f / sqrtf(wave_sum(s) * (1.f / 2048.f) + EPS);
    GAS unsigned long long* o8 = (GAS unsigned long long*)orow + lane;
#pragma unroll
    for (int j = 0; j < 8; ++j) { const f32x4 gg = gr[64 * j];
        o8[64 * j] = (unsigned long long)pk2(v[j].x * rs * gg.x, v[j].y * rs * gg.y) | ((unsigned long long)pk2(v[j].z * rs * gg.z, v[j].w * rs * gg.w) << 32); }
}
__device__ __forceinline__ void p0_prologue(const Ptrs& P, LAS unsigned char* lds, int vcu, int G, int wave, int lane, int tid) {
    LAS float* scr = (LAS float*)(lds + wave * 16384);
    const int gw = vcu * 8 + wave, NGW = G * 8;
    unsigned char* ws = P.ws;
    bf16* WIN = (bf16*)(ws + WS_WIN); bf16* WP = (bf16*)(ws + WS_WP); bf16* WOUT = (bf16*)(ws + WS_WOUT);
    constexpr int I_IN = 32 * 483, I_MEM = 32 * 64, I_P = 16 * 64, I_O = 32 * 64;
    constexpr int NITEMS = I_IN + I_MEM + 3 * I_P + I_O;
    for (int it = gw; it < NITEMS; it += NGW) {
        int r = it;
        if (r < I_IN) { p0_transpose_item<1>(P.in[10], 2048, D_IN, WIN, 0, scr, r, lane); continue; } r -= I_IN;
        if (r < I_MEM) { p0_transpose_item<0>(P.in[16], 2048, 2048, WIN, NPAD, scr, r, lane); continue; } r -= I_MEM;
        if (r < I_P) { p0_transpose_item<0>(P.in[20], 1024, 2048, WP, 0, scr, r, lane); continue; } r -= I_P;
        if (r < I_P) { p0_transpose_item<0>(P.in[21], 1024, 2048, WP, 2048, scr, r, lane); continue; } r -= I_P;
        if (r < I_P) { p0_transpose_item<0>(P.in[22], 1024, 2048, WP, 4096, scr, r, lane); continue; } r -= I_P;
        p0_transpose_item<0>(P.in[23], 2048, 2048, WOUT, 0, scr, r, lane);
    }
    bf16* XN = (bf16*)(ws + WS_XN);
    for (int m = gw; m < ROWS_A; m += NGW) {
        if (m < TP) rms_row_to_bf16(P.in[0] + (size_t)m * 2048, P.in[9], XN + (size_t)m * 2048, lane);
        else if (m < TP + TS) rms_row_to_bf16(P.in[1] + (size_t)(m - TP) * 2048, P.in[9], XN + (size_t)m * 2048, lane);
        else if (m < ROWS_T) { GAS v4u* o = (GAS v4u*)(XN + (size_t)m * 2048) + lane;
#pragma unroll
            for (int j = 0; j < 4; ++j) o[64 * j] = (v4u){0u, 0u, 0u, 0u}; }
        else rms_row_to_bf16(P.in[8] + (size_t)(m - ROWS_T) * 2048, P.in[15], XN + (size_t)m * 2048, lane);
    }
    const int gt = vcu * 512 + tid, NGT = G * 512;
    { bf16* WST = (bf16*)(ws + WS_WST); const float* w_s = P.in[18];
      for (int i = gt; i < 8 * 128 * 128; i += NGT) { const int p = (i >> 7) & 127, q = i & 127; WST[i] = (bf16)f2bf(q <= p ? w_s[i] : 0.f); } }
    { f32x2* CS = (f32x2*)(ws + WS_CS);
      for (int i = gt; i < 4100 * 96; i += NGT) { const int pp = i / 96, e = i - pp * 96; const int pos = pp < 4096 ? pp : PAST + (pp - 4096);
          const float fr = (e < 64) ? powf(10000.0f, -(float)e / 64.0f) : powf(10000.0f, -(float)(e - 64) / 32.0f);
          const float ang = (float)pos * fr; const double a = (double)ang;
          CS[i] = (f32x2){(float)cos(a), (float)sin(a)}; } }
}

struct SchedIn {
    int G, c;
    __device__ __forceinline__ bool next(int i, pg8::Unit& u) const {
        constexpr int nM = 33, nN = 61, nwg = nM * nN, NX = 8, WGM = 8;
        const int L = i * G + c;
        if (L >= nwg + 16) return false;
        if (L >= nwg) { const int k = L - nwg; u.pm = 33 + (k & 1); u.pn = 61 + (k >> 1); return true; }
        int wgid = L; { const int q = nwg / NX, r = nwg % NX, xcd = wgid % NX, off = wgid / NX; wgid = (xcd < r ? xcd * (q + 1) : r * (q + 1) + (xcd - r) * q) + off; }
        const int nig = WGM * nN, gid = wgid / nig, fm = gid * WGM, gsz = (nM - fm) < WGM ? (nM - fm) : WGM;
        u.pm = fm + ((wgid % nig) % gsz); u.pn = (wgid % nig) / gsz; return true;
    }
    __device__ __forceinline__ void a_ready(const pg8::Unit&) const {}
    __device__ __forceinline__ void done(const pg8::Unit&) const {}
};

struct EpiIn {
    static constexpr bool PERM = true, AFTER_DRAIN = false;
    float* out; unsigned char* ws; const float *g_q, *g_k, *g_mq, *g_mk; LAS float* xch;
    __device__ __forceinline__ void operator()(const pg8::f32x4 (&acc)[2][2][4][2], const pg8::Unit& u, int wr, int wc, int fr, int fq) const {
        asm volatile("" : "+v"(fr), "+v"(fq));
        asm volatile("" : "+s"(wr), "+s"(wc));
        const int pn = u.pn, pm = u.pm;
        const int rl0 = 64 * wr + fr;
        const int R0 = 256 * pm + rl0;
        const bool samp = (pm == 32);
        const int cl0 = 32 * wc + 8 * fq;
        const f32x2* CS = (const f32x2*)(ws + WS_CS);
#define ROWLOOP _Pragma("unroll") for (int ai = 0; ai < 2; ++ai) _Pragma("unroll") for (int m = 0; m < 4; ++m)
        if (pm >= 33) {
            const int Rm0 = 256 * (pm - 33) + rl0;
            if (pn <= 64) {
                const int head = pn - 61;
                ROWLOOP { float ss = 0.f;
#pragma unroll
                    for (int bj = 0; bj < 2; ++bj)
#pragma unroll
                        for (int n = 0; n < 2; ++n) { const pg8::f32x4 x = acc[ai][bj][m][n]; ss += (x[0] * x[0] + x[1] * x[1]) + (x[2] * x[2] + x[3] * x[3]); }
                    ss += __shfl_xor(ss, 16); ss += __shfl_xor(ss, 32);
                    if (fq == 0) xch[(128 * ai + 16 * m + rl0) * 8 + wc] = ss; }
                BAR_LDS();
                pg8::f32x4 gg[2][2];
#pragma unroll
                for (int bj = 0; bj < 2; ++bj)
#pragma unroll
                    for (int n = 0; n < 2; ++n) gg[bj][n] = *(const pg8::f32x4*)(g_mk + 128 * bj + cl0 + 4 * n);
                bf16* MK = (bf16*)(ws + WS_MK);
                ROWLOOP { const int rl = 128 * ai + 16 * m + rl0; const LAS float* xr = xch + rl * 8;
                    const float rs = 1.0f / sqrtf(((xr[0] + xr[1]) + (xr[2] + xr[3])) * (1.f / 256.f) + EPS);
                    const size_t ro = (size_t)(Rm0 + 128 * ai + 16 * m) * 1024 + head * 256;
#pragma unroll
                    for (int bj = 0; bj < 2; ++bj) { const pg8::f32x4 v0 = acc[ai][bj][m][0] * rs * gg[bj][0], v1 = acc[ai][bj][m][1] * rs * gg[bj][1];
                        float* o = out + O_MKP + ro + 128 * bj + cl0; *(pg8::f32x4*)o = v0; *(pg8::f32x4*)(o + 4) = v1;
                        *(v4u*)(MK + ro + 128 * bj + cl0) = (v4u){cvtpk(v0[0], v0[1]), cvtpk(v0[2], v0[3]), cvtpk(v1[0], v1[1]), cvtpk(v1[2], v1[3])}; } }
            } else {
                bf16* MV = (bf16*)(ws + WS_MV);
                ROWLOOP { const size_t ro = (size_t)(Rm0 + 128 * ai + 16 * m) * 1024 + (pn - 65) * 256;
#pragma unroll
                    for (int bj = 0; bj < 2; ++bj) { const pg8::f32x4 v0 = acc[ai][bj][m][0], v1 = acc[ai][bj][m][1];
                        float* o = out + O_MVP + ro + 128 * bj + cl0; *(pg8::f32x4*)o = v0; *(pg8::f32x4*)(o + 4) = v1;
                        *(v4u*)(MV + ro + 128 * bj + cl0) = (v4u){cvtpk(v0[0], v0[1]), cvtpk(v0[2], v0[3]), cvtpk(v1[0], v1[1]), cvtpk(v1[2], v1[3])}; } }
            }
            return;
        }
        if (pn < 6) {
            const bool isq = pn < 4; const float* G = isq ? g_q : g_k;
            ROWLOOP {
#pragma unroll
                for (int bj = 0; bj < 2; ++bj) { const pg8::f32x4 x = acc[ai][bj][m][0], y = acc[ai][bj][m][1];
                    float ss = ((x[0] * x[0] + x[1] * x[1]) + (x[2] * x[2] + x[3] * x[3])) + ((y[0] * y[0] + y[1] * y[1]) + (y[2] * y[2] + y[3] * y[3]));
                    ss += __shfl_xor(ss, 16); ss += __shfl_xor(ss, 32);
                    if (fq == 0) xch[(128 * ai + 16 * m + rl0) * 8 + wc * 2 + bj] = ss; } }
            BAR_LDS();
            const int d0 = 16 * wc + 4 * fq;
            const pg8::f32x4 g1 = *(const pg8::f32x4*)(G + d0), g2 = *(const pg8::f32x4*)(G + 64 + d0);
            bf16* QB = (bf16*)(ws + WS_QB); bf16* KB = (bf16*)(ws + WS_KB);
            ROWLOOP { const int rl = 128 * ai + 16 * m + rl0; const int R = R0 + 128 * ai + 16 * m;
                const int pidx = samp ? 4096 + ((R - TP) & 3) : (R & 4095);
                const pg8::f32x4 cs0 = *(const pg8::f32x4*)(CS + (size_t)pidx * 96 + d0), cs1 = *(const pg8::f32x4*)(CS + (size_t)pidx * 96 + d0 + 2);
                const float cc[4] = {cs0[0], cs0[2], cs1[0], cs1[2]}, sn[4] = {cs0[1], cs0[3], cs1[1], cs1[3]};
                const LAS float* xr = xch + rl * 8;
#pragma unroll
                for (int bj = 0; bj < 2; ++bj) {
                    const float rs = 1.0f / sqrtf(((xr[bj] + xr[2 + bj]) + (xr[4 + bj] + xr[6 + bj])) * (1.f / 128.f) + EPS);
                    const pg8::f32x4 y1 = acc[ai][bj][m][0] * rs * g1, y2 = acc[ai][bj][m][1] * rs * g2;
                    pg8::f32x4 o1, o2;
#pragma unroll
                    for (int e = 0; e < 4; ++e) { o1[e] = y1[e] * cc[e] - y2[e] * sn[e]; o2[e] = y2[e] * cc[e] + y1[e] * sn[e]; }
                    if (isq) { const size_t off = (size_t)R * 1024 + (2 * pn + bj) * 128 + d0;
                        *(u32x2*)(QB + off) = (u32x2){cvtpk(o1[0] * QS_A, o1[1] * QS_A), cvtpk(o1[2] * QS_A, o1[3] * QS_A)};
                        *(u32x2*)(QB + off + 64) = (u32x2){cvtpk(o2[0] * QS_A, o2[1] * QS_A), cvtpk(o2[2] * QS_A, o2[3] * QS_A)};
                    } else { const int hd = 2 * (pn - 4) + bj; const size_t off = (size_t)R * 512 + hd * 128 + d0;
                        *(u32x2*)(KB + off) = (u32x2){cvtpk(o1[0], o1[1]), cvtpk(o1[2], o1[3])};
                        *(u32x2*)(KB + off + 64) = (u32x2){cvtpk(o2[0], o2[1]), cvtpk(o2[2], o2[3])};
                        if (!samp) { float* o = out + O_KP + off; *(pg8::f32x4*)o = o1; *(pg8::f32x4*)(o + 64) = o2; }
                        else if (R - TP < TS) { float* o = out + O_KS + (size_t)(R - TP) * 512 + hd * 128 + d0; *(pg8::f32x4*)o = o1; *(pg8::f32x4*)(o + 64) = o2; } } } }
            return;
        }
        if (pn < 8) {
            bf16* VB = (bf16*)(ws + WS_VB);
            ROWLOOP { const int R = R0 + 128 * ai + 16 * m;
#pragma unroll
                for (int bj = 0; bj < 2; ++bj) { const pg8::f32x4 v0 = acc[ai][bj][m][0], v1 = acc[ai][bj][m][1]; const int col = 256 * (pn - 6) + 128 * bj + cl0;
                    *(v4u*)(VB + (size_t)R * 512 + col) = (v4u){cvtpk(v0[0], v0[1]), cvtpk(v0[2], v0[3]), cvtpk(v1[0], v1[1]), cvtpk(v1[2], v1[3])};
                    if (!samp) { float* o = out + O_VP + (size_t)R * 512 + col; *(pg8::f32x4*)o = v0; *(pg8::f32x4*)(o + 4) = v1; }
                    else if (R - TP < TS) { float* o = out + O_VS + (size_t)(R - TP) * 512 + col; *(pg8::f32x4*)o = v0; *(pg8::f32x4*)(o + 4) = v1; } } }
            return;
        }
        if (pn < 12) {
            _Float16* QI = (_Float16*)(ws + WS_QI);
            const int dlo = 16 * (wc & 1) + 4 * fq;
            ROWLOOP { const int R = R0 + 128 * ai + 16 * m; const int pidx = samp ? 4096 + ((R - TP) & 3) : (R & 4095);
                const pg8::f32x4 cs0 = *(const pg8::f32x4*)(CS + (size_t)pidx * 96 + 64 + dlo), cs1 = *(const pg8::f32x4*)(CS + (size_t)pidx * 96 + 64 + dlo + 2);
                const float cc[4] = {cs0[0], cs0[2], cs1[0], cs1[2]}, sn[4] = {cs0[1], cs0[3], cs1[1], cs1[3]};
#pragma unroll
                for (int bj = 0; bj < 2; ++bj) { const pg8::f32x4 x1 = acc[ai][bj][m][0], x2 = acc[ai][bj][m][1]; pg8::f32x4 o1, o2;
#pragma unroll
                    for (int e = 0; e < 4; ++e) { o1[e] = (x1[e] * cc[e] - x2[e] * sn[e]) * 0.125f; o2[e] = (x2[e] * cc[e] + x1[e] * sn[e]) * 0.125f; }
                    const int head = 4 * (pn - 8) + 2 * bj + (wc >> 1); const size_t off = (size_t)R * 1024 + head * 64 + dlo;
                    *(u32x2*)(QI + off) = (u32x2){cvtpk_h(o1[0], o1[1]), cvtpk_h(o1[2], o1[3])};
                    *(u32x2*)(QI + off + 32) = (u32x2){cvtpk_h(o2[0], o2[1]), cvtpk_h(o2[2], o2[3])}; } }
            return;
        }
        if (pn == 60) {
            _Float16* KI = (_Float16*)(ws + WS_KI); float* WI = (float*)(ws + WS_WI);
            const int dlo = 16 * (wc & 1) + 4 * fq;
            ROWLOOP { const int R = R0 + 128 * ai + 16 * m; const int pidx = samp ? 4096 + ((R - TP) & 3) : (R & 4095);
                const pg8::f32x4 x1 = acc[ai][0][m][0], x2 = acc[ai][0][m][1];
                if (wc < 2) {
                    const pg8::f32x4 cs0 = *(const pg8::f32x4*)(CS + (size_t)pidx * 96 + 64 + dlo), cs1 = *(const pg8::f32x4*)(CS + (size_t)pidx * 96 + 64 + dlo + 2);
                    const float cc[4] = {cs0[0], cs0[2], cs1[0], cs1[2]}, sn[4] = {cs0[1], cs0[3], cs1[1], cs1[3]};
                    pg8::f32x4 o1, o2;
#pragma unroll
                    for (int e = 0; e < 4; ++e) { o1[e] = x1[e] * cc[e] - x2[e] * sn[e]; o2[e] = x2[e] * cc[e] + x1[e] * sn[e]; }
                    const size_t off = (size_t)R * 64 + dlo;
                    *(u32x2*)(KI + off) = (u32x2){cvtpk_h(o1[0], o1[1]), cvtpk_h(o1[2], o1[3])};
                    *(u32x2*)(KI + off + 32) = (u32x2){cvtpk_h(o2[0], o2[1]), cvtpk_h(o2[2], o2[3])};
                    if (!samp) { float* o = out + O_KIP + off; *(pg8::f32x4*)o = o1; *(pg8::f32x4*)(o + 32) = o2; }
                    else if (R - TP < TS) { float* o = out + O_KIS + (size_t)(R - TP) * 64 + dlo; *(pg8::f32x4*)o = o1; *(pg8::f32x4*)(o + 32) = o2; }
                } else if (wc == 2 && fq < 2) {
                    float* o = WI + (size_t)R * 16 + 8 * fq; *(pg8::f32x4*)o = x1 * 0.25f; *(pg8::f32x4*)(o + 4) = x2 * 0.25f;
                } }
            return;
        }
        if (pn >= 20 && pn < 24) {
            float* BV = (float*)(ws + WS_BV); float* SSQ = (float*)(ws + WS_SSQ);
            ROWLOOP { const int R = R0 + 128 * ai + 16 * m; float ss = 0.f;
#pragma unroll
                for (int bj = 0; bj < 2; ++bj) { const pg8::f32x4 v0 = acc[ai][bj][m][0], v1 = acc[ai][bj][m][1];
                    ss += ((v0[0] * v0[0] + v0[1] * v0[1]) + (v0[2] * v0[2] + v0[3] * v0[3])) + ((v1[0] * v1[0] + v1[1] * v1[1]) + (v1[2] * v1[2] + v1[3] * v1[3]));
                    float* o = BV + (size_t)R * 1024 + 256 * (pn - 20) + 128 * bj + cl0; *(pg8::f32x4*)o = v0; *(pg8::f32x4*)(o + 4) = v1; }
                ss += __shfl_xor(ss, 16); ss += __shfl_xor(ss, 32);
                if (fq == 0) SSQ[(size_t)R * 16 + (pn - 20) * 4 + wc] = ss; }
            return;
        }
        if (pn >= 28 && pn < 32) {
            const int head = pn - 28;
            ROWLOOP { float ss = 0.f;
#pragma unroll
                for (int bj = 0; bj < 2; ++bj)
#pragma unroll
                    for (int n = 0; n < 2; ++n) { const pg8::f32x4 x = acc[ai][bj][m][n]; ss += (x[0] * x[0] + x[1] * x[1]) + (x[2] * x[2] + x[3] * x[3]); }
                ss += __shfl_xor(ss, 16); ss += __shfl_xor(ss, 32);
                if (fq == 0) xch[(128 * ai + 16 * m + rl0) * 8 + wc] = ss; }
            BAR_LDS();
            pg8::f32x4 gg[2][2];
#pragma unroll
            for (int bj = 0; bj < 2; ++bj)
#pragma unroll
                for (int n = 0; n < 2; ++n) gg[bj][n] = *(const pg8::f32x4*)(g_mq + 128 * bj + cl0 + 4 * n) * QS_C;
            bf16* QC = (bf16*)(ws + WS_QC);
            ROWLOOP { const int rl = 128 * ai + 16 * m + rl0; const LAS float* xr = xch + rl * 8;
                const float rs = 1.0f / sqrtf(((xr[0] + xr[1]) + (xr[2] + xr[3])) * (1.f / 256.f) + EPS);
                const size_t ro = (size_t)(R0 + 128 * ai + 16 * m) * 1024 + head * 256;
#pragma unroll
                for (int bj = 0; bj < 2; ++bj) { const pg8::f32x4 v0 = acc[ai][bj][m][0] * rs * gg[bj][0], v1 = acc[ai][bj][m][1] * rs * gg[bj][1];
                    *(v4u*)(QC + ro + 128 * bj + cl0) = (v4u){cvtpk(v0[0], v0[1]), cvtpk(v0[2], v0[3]), cvtpk(v1[0], v1[1]), cvtpk(v1[2], v1[3])}; } }
            return;
        }
        int mode; bf16* dst; int ld, colt;
        if (pn < 16) { mode = 1; dst = (bf16*)(ws + WS_SGA); ld = 1024; colt = 256 * (pn - 12); }
        else if (pn < 20) { mode = 0; dst = (bf16*)(ws + WS_BU); ld = 1024; colt = 256 * (pn - 16); }
        else if (pn < 28) { mode = 1; dst = (bf16*)(ws + WS_SGB); ld = 1024; colt = 256 * (pn - 24); }
        else if (pn < 36) { mode = 1; dst = (bf16*)(ws + WS_SGC); ld = 1024; colt = 256 * (pn - 32); }
        else { mode = 2; const int k = pn - 36; dst = (bf16*)(ws + WS_R) + (size_t)(k >> 3) * R_STRIDE; ld = 2048; colt = 256 * (k & 7); }
        ROWLOOP { const int R = R0 + 128 * ai + 16 * m;
#pragma unroll
            for (int bj = 0; bj < 2; ++bj) { pg8::f32x4 v0 = acc[ai][bj][m][0], v1 = acc[ai][bj][m][1];
                if (mode == 1) {
#pragma unroll
                    for (int e = 0; e < 4; ++e) { v0[e] = siluf_(v0[e]); v1[e] = siluf_(v1[e]); } }
                else if (mode == 2) {
#pragma unroll
                    for (int e = 0; e < 4; ++e) { v0[e] = sigmoidf_(v0[e]); v1[e] = sigmoidf_(v1[e]); } }
                *(v4u*)(dst + (size_t)R * ld + colt + 128 * bj + cl0) = (v4u){cvtpk(v0[0], v0[1]), cvtpk(v0[2], v0[3]), cvtpk(v1[0], v1[1]), cvtpk(v1[2], v1[3])}; } }
#undef ROWLOOP
    }
};

typedef short v4i16_t __attribute__((ext_vector_type(4)));
#define KSWZ(row, colB) ((row) * 256 + ((colB) ^ (((row) & 7) << 4)))
__device__ __forceinline__ int v_st(int k, int c) { const int kk = (k & ~0xC) | ((k & 4) << 1) | ((k & 8) >> 1); return ((kk >> 3) * 4 + (c >> 5)) * 512 + ((kk & 7) * 32 + (c & 31)) * 2; }
__device__ __forceinline__ int v_rd_base(int lane) { return ((lane & 3) << 3) | (((lane >> 2) & 3) << 6) | (((lane >> 4) & 1) << 5) | (((lane >> 5) & 1) << 8); }
__device__ __forceinline__ s16x4 vtr(const LAS unsigned char* p) { return __builtin_bit_cast(s16x4, __builtin_amdgcn_ds_read_tr16_b64_v4i16((LAS v4i16_t*)p)); }
#define VFRAG(l_, h_) (bf16x8){(l_)[0], (l_)[1], (l_)[2], (l_)[3], (h_)[0], (h_)[1], (h_)[2], (h_)[3]}
#define PK4(P, B_, OUT) do { const unsigned a0 = cvtpk(P[B_ + 0], P[B_ + 1]), a1 = cvtpk(P[B_ + 2], P[B_ + 3]);                       \
        const unsigned b0 = cvtpk(P[B_ + 4], P[B_ + 5]), b1 = cvtpk(P[B_ + 6], P[B_ + 7]);                                          \
        auto r0 = __builtin_amdgcn_permlane32_swap(a0, b0, false, false); auto r1 = __builtin_amdgcn_permlane32_swap(a1, b1, false, false); \
        v4u w_ = {r0[0], r1[0], r0[1], r1[1]}; OUT = __builtin_bit_cast(bf16x8, w_); } while (0)
__device__ __forceinline__ float relu_s(float a) { const int b = __builtin_bit_cast(int, a); return __builtin_bit_cast(float, b > 0 ? b : 0); }
__device__ __forceinline__ float wave_max(float v) {
#pragma unroll
    for (int o = 1; o < 64; o <<= 1) v = fmaxf(v, __shfl_xor(v, o));
    return v;
}
__device__ __forceinline__ float logit_bound(const float* gq, const float* gk, int D, int lane) {
    float a = 0.f, c = 0.f;
    for (int i = lane; i < D; i += 64) { a = fmaxf(a, fabsf(gq[i])); c = fmaxf(c, fabsf(gk[i])); }
    return sqrtf((float)D) * wave_max(a) * wave_max(c) * LOG2E;
}

__device__ __forceinline__ void idx_stage_offsets(unsigned (&voff)[4], int wid, int lane) {
#pragma unroll
    for (int i = 0; i < 4; ++i) { const int pc = wid * 4 + i; const int r = 8 * pc + (lane >> 3); const int ch = (lane & 7) ^ ((r >> 1) & 7);
        voff[i] = (unsigned)(r * 128 + ch * 16); asm volatile("" : "+v"(voff[i])); }
}
__device__ __forceinline__ void idx_stage_chunk(LAS unsigned char* buf, const char* cbase  , const unsigned (&voff)[4], int wid) {
#pragma unroll
    for (int i = 0; i < 4; ++i)
        __builtin_amdgcn_global_load_lds((const unsigned*)(cbase + voff[i]), (LAS unsigned*)(buf + (wid * 4 + i) * 1024), 16, 0, 0);
}
#define IDX_COUNT(PRED, CNT) { unsigned cl_ = 0; _Pragma("unroll") for (int j = 0; j < NT; ++j) { cl_ += (PRED) ? 1u : 0u; if ((j & 15) == 15) __builtin_amdgcn_sched_barrier(0); } \
        _Pragma("unroll") for (int o_ = 1; o_ < 32; o_ <<= 1) cl_ += __shfl_xor(cl_, o_); CNT = cl_; }
template <int NCH>
__device__ __forceinline__ void indexer_unit(LAS unsigned char* lds, const unsigned char* ws, int b, int p, int wid, int lane) {
    constexpr int NT = 8 * NCH;
    const _Float16* QI = (const _Float16*)(ws + WS_QI); const _Float16* KIb = (const _Float16*)(ws + WS_KI) + (size_t)b * 4096 * 64;
    const float* WI = (const float*)(ws + WS_WI); unsigned* MASK = (unsigned*)(ws + WS_MASK);
    const int r32 = lane & 31, hi = lane >> 5;
    const int t0 = 16 * p + 2 * wid;
    const float NEG = -__builtin_inff();
    h8 qa[4];
    { const int tok = t0 + ((lane >> 2) & 1), head = (lane & 3) + 4 * (r32 >> 3);
      const _Float16* qp = QI + ((size_t)(b * 4096 + tok) * 1024 + head * 64 + 8 * hi);
#pragma unroll
      for (int s = 0; s < 4; ++s) qa[s] = *(const h8*)(qp + 16 * s); }
    float w[16];
    { const float* wp = WI + (size_t)(b * 4096 + t0 + hi) * 16;
#pragma unroll
      for (int k = 0; k < 4; ++k) { const f32x4 t = *(const f32x4*)(wp + 4 * k); w[4 * k] = t[0]; w[4 * k + 1] = t[1]; w[4 * k + 2] = t[2]; w[4 * k + 3] = t[3]; } }
    float sc[NT];
    unsigned voff[4]; idx_stage_offsets(voff, wid, lane);
    const char* kib = (const char*)KIb;
    idx_stage_chunk(lds, kib, voff, wid);
    asm volatile("s_waitcnt vmcnt(0)" ::: "memory"); __syncthreads();
    const int tcur = t0 + hi - r32;
    const LAS unsigned char* kb_base[4];
#pragma unroll
    for (int s = 0; s < 4; ++s) { kb_base[s] = lds + r32 * 128 + (((2 * s + hi) ^ ((r32 >> 1) & 7)) << 4); asm volatile("" : "+v"(kb_base[s])); }
#pragma unroll
    for (int c = 0; c < NCH; ++c) {
        if (c + 1 < NCH) idx_stage_chunk(lds + ((c + 1) & 1) * 32768, kib + (size_t)(c + 1) * 32768, voff, wid);
#ifdef DBG_SERIAL_DMA
        asm volatile("s_waitcnt vmcnt(0)" ::: "memory"); __syncthreads();
#endif
#pragma unroll
        for (int i = 0; i < 8; ++i) { const int j = 8 * c + i;
            f32x16 acc = {};
#pragma unroll
            for (int s = 0; s < 4; ++s) {
                const h8 kb = *(const LAS h8*)(kb_base[s] + ((c & 1) * 32768 + i * 4096));
                acc = __builtin_amdgcn_mfma_f32_32x32x16_f16(qa[s], kb, acc, 0, 0, 0); }
            float s_ = 0.f;
#pragma unroll
            for (int r = 0; r < 16; ++r) s_ = fmaf(relu_s(acc[r]), w[r], s_);
            s_ = (32 * j <= tcur) ? s_ : NEG;
            asm volatile("" : "+v"(s_));
            sc[j] = s_;
            __builtin_amdgcn_sched_barrier(0);
        }
        asm volatile("s_waitcnt vmcnt(0)" ::: "memory"); __syncthreads();
    }
    float thr = NEG, tv = 0.f; bool tie = false; int X = 0;
    if (t0 + 2 > TOPK) {
        float mn = __builtin_inff(), mx = NEG;
#pragma unroll
        for (int j = 0; j < NT; ++j) { const float v = sc[j]; mx = fmaxf(mx, v); mn = fminf(mn, v == NEG ? __builtin_inff() : v); }
#pragma unroll
        for (int o = 1; o < 32; o <<= 1) { mn = fminf(mn, __shfl_xor(mn, o)); mx = fmaxf(mx, __shfl_xor(mx, o)); }
        float lo = mn - (mx - mn) - 1.0f - fabsf(mn) * 1e-6f, hv = mx; bool done = false;
        for (int it = 0; it < 256; ++it) {
            const float mid = 0.5f * (lo + hv);
            const bool adj = !(mid > lo && mid < hv);
            unsigned c;
            IDX_COUNT(sc[j] > mid, c)
            if (!done) { if (adj) { done = true; tie = true; tv = hv; thr = hv; }
                         else if (c == (unsigned)TOPK) { thr = mid; done = true; }
                         else if (c > (unsigned)TOPK) lo = mid; else hv = mid; }
            if (__all(done)) break;
        }
        if (__any(tie)) {
            unsigned cgt;
            IDX_COUNT(sc[j] > tv, cgt)
            const int need = TOPK - (int)cgt;
            int loX = 0, hiX = 4096;
            for (int it = 0; it < 12; ++it) { const int midX = (loX + hiX) >> 1; unsigned eq; asm volatile("" : "+v"(tv));
                IDX_COUNT(sc[j] == tv && (32 * j + r32) < midX, eq)
                if ((int)eq >= need) hiX = midX; else loX = midX; }
            X = hiX;
        }
    }
    unsigned W00 = 0, W01 = 0, W10 = 0, W11 = 0;
#pragma unroll
    for (int j = 0; j < NT; ++j) {
        const bool sel = (sc[j] > thr) || (tie && sc[j] == tv && (32 * j + r32) < X);
        const unsigned long long bm = __ballot(sel);
        const unsigned blo = (unsigned)bm, bhi = (unsigned)(bm >> 32);
        if (j < 64) { asm volatile("s_nop 1\n\tv_writelane_b32 %0, %1, %2" : "+v"(W00) : "s"(blo), "n"(j & 63)); asm volatile("s_nop 1\n\tv_writelane_b32 %0, %1, %2" : "+v"(W10) : "s"(bhi), "n"(j & 63)); }
        else { asm volatile("s_nop 1\n\tv_writelane_b32 %0, %1, %2" : "+v"(W01) : "s"(blo), "n"(j & 63)); asm volatile("s_nop 1\n\tv_writelane_b32 %0, %1, %2" : "+v"(W11) : "s"(bhi), "n"(j & 63)); }
        if ((j & 15) == 15) __builtin_amdgcn_sched_barrier(0); }
    unsigned* mr = MASK + (size_t)(b * 4096 + t0) * 128;
    mr[lane] = W00; mr[64 + lane] = W01; mr[128 + lane] = W10; mr[192 + lane] = W11;
}
__device__ __forceinline__ void indexer_dispatch(LAS unsigned char* lds, const unsigned char* ws, int b, int p, int wid, int lane) {
#ifdef IDX_FORCE
    indexer_unit<IDX_FORCE>(lds, ws, b, p, wid, lane); return;
#endif
    if (p < 64) indexer_unit<4>(lds, ws, b, p, wid, lane);
    else if (p < 128) indexer_unit<8>(lds, ws, b, p, wid, lane);
    else if (p < 192) indexer_unit<12>(lds, ws, b, p, wid, lane);
    else indexer_unit<16>(lds, ws, b, p, wid, lane);
}

__device__ __forceinline__ void chunkmix_unit(LAS unsigned char* lds, const Ptrs& P, int cg, int g, int tid, int wid, int lane) {
    const unsigned char* ws = P.ws;
    const float* BV = (const float*)(ws + WS_BV); const float* SSQ = (const float*)(ws + WS_SSQ);
    const bf16* BU = (const bf16*)(ws + WS_BU); const bf16* SGB = (const bf16*)(ws + WS_SGB); const bf16* WST = (const bf16*)(ws + WS_WST);
    bf16* ZB = (bf16*)(ws + WS_Z) + Z_STRIDE;
    const float* gsgu = P.in[17]; const float* b_s = P.in[19];
    const int Rbase = cg * 128;
    { const int sr = tid >> 4, scol = (tid & 15) * 8;
      const f32x4 g0 = *(const f32x4*)(gsgu + g * 128 + scol), g1 = *(const f32x4*)(gsgu + g * 128 + scol + 4);
#pragma unroll
      for (int k = 0; k < 4; ++k) { const int q = sr + 32 * k; const size_t R = (size_t)(Rbase + q);
          const f32x4 s0 = *(const f32x4*)(SSQ + R * 16), s1 = *(const f32x4*)(SSQ + R * 16 + 4), s2 = *(const f32x4*)(SSQ + R * 16 + 8), s3 = *(const f32x4*)(SSQ + R * 16 + 12);
          const float ss = (((s0[0] + s0[1]) + (s0[2] + s0[3])) + ((s1[0] + s1[1]) + (s1[2] + s1[3]))) + (((s2[0] + s2[1]) + (s2[2] + s2[3])) + ((s3[0] + s3[1]) + (s3[2] + s3[3])));
          const float rs = 1.0f / sqrtf(ss * (1.f / 1024.f) + EPS);
          const f32x4 x0 = *(const f32x4*)(BV + R * 1024 + g * 128 + scol) * rs * g0, x1 = *(const f32x4*)(BV + R * 1024 + g * 128 + scol + 4) * rs * g1;
          *(LAS v4u*)(lds + (q >> 6) * 16384 + v_st(q & 63, scol)) = (v4u){cvtpk(x0[0], x0[1]), cvtpk(x0[2], x0[3]), cvtpk(x1[0], x1[1]), cvtpk(x1[2], x1[3])}; } }
    __syncthreads();
    const int pb = wid & 3, chh = wid >> 2, r32 = lane & 31, hi = lane >> 5;
    f32x16 o[2]; o[0] = f32x16{}; o[1] = f32x16{};
    const bf16* wsp = WST + ((size_t)(g * 128 + 32 * pb + r32) * 128 + 8 * hi);
    const LAS unsigned char* vp = lds + v_rd_base(lane);
#pragma unroll
    for (int ks = 0; ks < 8; ++ks) {
        if (ks < 2 * pb + 2) {
            const bf16x8 pa = *(const bf16x8*)(wsp + 16 * ks);
#pragma unroll
            for (int d0l = 0; d0l < 2; ++d0l) { const int d0 = 2 * chh + d0l;
                const s16x4 lo = vtr(vp + (ks >> 2) * 16384 + d0 * 512 + (ks & 3) * 4096), hh = vtr(vp + (ks >> 2) * 16384 + d0 * 512 + (ks & 3) * 4096 + 2048);
                o[d0l] = __builtin_amdgcn_mfma_f32_32x32x16_bf16(pa, VFRAG(lo, hh), o[d0l], 0, 0, 0); }
        }
    }
#pragma unroll
    for (int d0l = 0; d0l < 2; ++d0l)
#pragma unroll
        for (int r = 0; r < 16; ++r) { const int pp = 32 * pb + crow(r, hi), c = 32 * (2 * chh + d0l) + r32; const size_t off = (size_t)(Rbase + pp) * 1024 + g * 128 + c;
            const float s = o[d0l][r] + b_s[g * 128 + pp];
            const float val = bf2f(BU[off]) * s * bf2f(SGB[off]);
            const float vn_ = __shfl_xor(val, 1);
            if ((r32 & 1) == 0) *(unsigned*)(ZB + off) = cvtpk(val, vn_); }
    __syncthreads();
}

__device__ __forceinline__ void memattn_unit(LAS unsigned char* lds, LAS float* xch, const Ptrs& P, int b, int h, int qb, float M2, int tid, int wid, int lane) {
    const unsigned char* ws = P.ws;
    const bf16* QC = (const bf16*)(ws + WS_QC); const bf16* MK = (const bf16*)(ws + WS_MK); const bf16* MV = (const bf16*)(ws + WS_MV); const bf16* SGC = (const bf16*)(ws + WS_SGC);
    bf16* ZC = (bf16*)(ws + WS_Z) + 2 * Z_STRIDE;
    const int rg = wid & 3, par = wid >> 2, r32 = lane & 31, hi = lane >> 5;
    const size_t Rq = (size_t)b * 4096 + 128 * qb + 32 * rg + r32;
#pragma unroll
    for (int half = 0; half < 2; ++half) { v4u st[8];
#pragma unroll
        for (int i = 0; i < 8; ++i) { const int cidx = tid + 512 * (8 * half + i); const int key = cidx >> 5, c16 = cidx & 31;
            st[i] = *(const v4u*)(MK + (size_t)(b * 256 + key) * 1024 + h * 256 + c16 * 8); }
#pragma unroll
        for (int i = 0; i < 8; ++i) { const int cidx = tid + 512 * (8 * half + i); const int key = cidx >> 5, c16 = cidx & 31;
            *(LAS v4u*)(lds + (key >> 6) * 32768 + (c16 >> 4) * 16384 + KSWZ(key & 63, (c16 & 15) * 16)) = st[i]; } }
    __syncthreads();
    f32x16 p[2][2];
#pragma unroll
    for (int tt = 0; tt < 2; ++tt)
#pragma unroll
        for (int k = 0; k < 2; ++k)
#pragma unroll
            for (int r = 0; r < 16; ++r) p[tt][k][r] = -M2;
    { const bf16* qp = QC + Rq * 1024 + h * 256 + 8 * hi;
#pragma unroll
      for (int s = 0; s < 16; ++s) { const bf16x8 qf = *(const bf16x8*)(qp + 16 * s);
#pragma unroll
          for (int tt = 0; tt < 2; ++tt) { const LAS unsigned char* a = lds + (2 * par + tt) * 32768 + (s >> 3) * 16384 + KSWZ(r32, ((s & 7) * 16 + hi * 8) * 2);
              const bf16x8 b0 = *(const LAS bf16x8*)a, b1 = *(const LAS bf16x8*)(a + 32 * 256);
              p[tt][0] = __builtin_amdgcn_mfma_f32_32x32x16_bf16(b0, qf, p[tt][0], 0, 0, 0);
              p[tt][1] = __builtin_amdgcn_mfma_f32_32x32x16_bf16(b1, qf, p[tt][1], 0, 0, 0); } } }
    float l = 0.f; bf16x8 pa[2][4];
#pragma unroll
    for (int tt = 0; tt < 2; ++tt) {
#pragma unroll
        for (int k = 0; k < 2; ++k)
#pragma unroll
            for (int r = 0; r < 16; ++r) { const float e = __builtin_amdgcn_exp2f(p[tt][k][r]); p[tt][k][r] = e; l += e; }
        PK4(p[tt][0], 0, pa[tt][0]); PK4(p[tt][0], 8, pa[tt][1]); PK4(p[tt][1], 0, pa[tt][2]); PK4(p[tt][1], 8, pa[tt][3]);
    }
    __syncthreads();
#pragma unroll
    for (int half = 0; half < 2; ++half) { v4u st[8];
#pragma unroll
        for (int i = 0; i < 8; ++i) { const int cidx = tid + 512 * (8 * half + i); const int key = cidx >> 5, c16 = cidx & 31;
            st[i] = *(const v4u*)(MV + (size_t)(b * 256 + key) * 1024 + h * 256 + c16 * 8); }
#pragma unroll
        for (int i = 0; i < 8; ++i) { const int cidx = tid + 512 * (8 * half + i); const int key = cidx >> 5, c16 = cidx & 31;
            *(LAS v4u*)(lds + (key >> 6) * 32768 + (c16 >> 4) * 16384 + v_st(key & 63, (c16 & 15) * 8)) = st[i]; } }
    __syncthreads();
    f32x16 o[8];
#pragma unroll
    for (int d0 = 0; d0 < 8; ++d0) o[d0] = f32x16{};
#pragma unroll
    for (int tt = 0; tt < 2; ++tt)
#pragma unroll
        for (int d0 = 0; d0 < 8; ++d0) { const LAS unsigned char* vp = lds + (2 * par + tt) * 32768 + (d0 >> 2) * 16384 + v_rd_base(lane) + (d0 & 3) * 512;
#pragma unroll
            for (int ks = 0; ks < 4; ++ks) { const s16x4 lo = vtr(vp + ks * 4096), hh = vtr(vp + ks * 4096 + 2048);
                o[d0] = __builtin_amdgcn_mfma_f32_32x32x16_bf16(pa[tt][ks], VFRAG(lo, hh), o[d0], 0, 0, 0); } }
    __syncthreads();
    l += __shfl_xor(l, 32);
    LAS float* OM = (LAS float*)lds + rg * 8192; LAS float* LM = xch + rg * 32; LAS float* LM2 = xch + 128 + wid * 32;
    if (par == 1) {
#pragma unroll
        for (int d0 = 0; d0 < 8; ++d0)
#pragma unroll
            for (int r = 0; r < 16; ++r) OM[(d0 * 16 + r) * 64 + lane] = o[d0][r];
        if (hi == 0) LM[r32] = l;
    }
    __syncthreads();
    if (par == 0) {
        l += LM[r32];
        if (hi == 0) LM2[r32] = l;
        float rl[16];
#pragma unroll
        for (int r = 0; r < 16; ++r) rl[r] = 1.0f / LM2[crow(r, hi)];
#pragma unroll
        for (int d0 = 0; d0 < 8; ++d0)
#pragma unroll
            for (int r = 0; r < 16; ++r) { const size_t off = ((size_t)b * 4096 + 128 * qb + 32 * rg + crow(r, hi)) * 1024 + h * 256 + 32 * d0 + r32;
                const float val = (o[d0][r] + OM[(d0 * 16 + r) * 64 + lane]) * rl[r] * bf2f(SGC[off]);
                const float vn_ = __shfl_xor(val, 1);
                if ((r32 & 1) == 0) *(unsigned*)(ZC + off) = cvtpk(val, vn_); }
    }
    __syncthreads();
}

__device__ __forceinline__ void sample_scores_unit(const Ptrs& P, int db, int tp, int slot, int lane) {
    const unsigned char* ws = P.ws;
    const _Float16* QI = (const _Float16*)(ws + WS_QI); const _Float16* KI = (const _Float16*)(ws + WS_KI); const float* WI = (const float*)(ws + WS_WI);
    float* SS = (float*)(ws + WS_SS); const float* ckidx = P.in[4]; const int* PT = (const int*)P.in[7];
    const int r32 = lane & 31, hi = lane >> 5, i0 = 2 * tp; const int Rs0 = TP + db * 4 + i0;
    const float NEG = -__builtin_inff();
    h8 qa[4];
    { const int tok = Rs0 + ((lane >> 2) & 1), head = (lane & 3) + 4 * (r32 >> 3);
      const _Float16* qp = QI + ((size_t)tok * 1024 + head * 64 + 8 * hi);
#pragma unroll
      for (int s = 0; s < 4; ++s) qa[s] = *(const h8*)(qp + 16 * s); }
    float w[16];
    { const float* wp = WI + (size_t)(Rs0 + hi) * 16;
#pragma unroll
      for (int k = 0; k < 4; ++k) { const f32x4 t = *(const f32x4*)(wp + 4 * k); w[4 * k] = t[0]; w[4 * k + 1] = t[1]; w[4 * k + 2] = t[2]; w[4 * k + 3] = t[3]; } }
    const int ntl = (slot == 127) ? 5 : 4;
    for (int tl = 0; tl < ntl; ++tl) {
        const int j = (tl < 4) ? slot * 4 + tl : 512; const int key = 32 * j + r32;
        h8 kb[4];
        if (j < 512) { const int page = PT[db * 128 + (key >> 7)]; const float* src = ckidx + ((size_t)page * 128 + (key & 127)) * 64 + 8 * hi;
#pragma unroll
            for (int s = 0; s < 4; ++s) { const f32x4 a = *(const f32x4*)(src + 16 * s), c = *(const f32x4*)(src + 16 * s + 4);
                kb[s] = (h8){(_Float16)a[0], (_Float16)a[1], (_Float16)a[2], (_Float16)a[3], (_Float16)c[0], (_Float16)c[1], (_Float16)c[2], (_Float16)c[3]}; } }
        else { const _Float16* src = KI + (size_t)(TP + db * 4 + (r32 < 4 ? r32 : 0)) * 64 + 8 * hi;
#pragma unroll
            for (int s = 0; s < 4; ++s) kb[s] = *(const h8*)(src + 16 * s); }
        f32x16 acc = {};
#pragma unroll
        for (int s = 0; s < 4; ++s) acc = __builtin_amdgcn_mfma_f32_32x32x16_f16(qa[s], kb[s], acc, 0, 0, 0);
        float s_ = 0.f;
#pragma unroll
        for (int r = 0; r < 16; ++r) s_ = fmaf(relu_s(acc[r]), w[r], s_);
        SS[(size_t)(db * 4 + i0 + hi) * SS_LD + key] = (key <= PAST + i0 + hi) ? s_ : NEG;
    }
}

__device__ __forceinline__ void sample_chunkmix(const Ptrs& P, int db, int tid) {
    const unsigned char* ws = P.ws;
    const float* BV = (const float*)(ws + WS_BV); const float* SSQ = (const float*)(ws + WS_SSQ);
    const bf16* BU = (const bf16*)(ws + WS_BU); const bf16* SGB = (const bf16*)(ws + WS_SGB); bf16* ZB = (bf16*)(ws + WS_Z) + Z_STRIDE;
    const float* gsgu = P.in[17]; const float* w_s = P.in[18]; const float* b_s = P.in[19];
    float rs[4];
#pragma unroll
    for (int q = 0; q < 4; ++q) { float ss = 0.f; for (int i = 0; i < 16; ++i) ss += __hip_atomic_load(SSQ + (size_t)(TP + db * 4 + q) * 16 + i, __ATOMIC_RELAXED, __HIP_MEMORY_SCOPE_AGENT);
        rs[q] = 1.0f / sqrtf(ss * (1.f / 1024.f) + EPS); }
    for (int c = tid; c < 1024; c += 512) { const int g = c >> 7; float vn[4];
#pragma unroll
        for (int q = 0; q < 4; ++q) { vn[q] = BV[(size_t)(TP + db * 4 + q) * 1024 + c] * rs[q] * gsgu[c]; P.out[O_CVS + (size_t)(db * 4 + q) * 1024 + c] = vn[q]; }
#pragma unroll
        for (int pp = 0; pp < 4; ++pp) { float s = b_s[g * 128 + pp];
#pragma unroll
            for (int q = 0; q < 4; ++q) if (q <= pp) s += w_s[(size_t)(g * 128 + pp) * 128 + q] * vn[q];
            const size_t off = (size_t)(TP + db * 4 + pp) * 1024 + c;
            ZB[off] = (bf16)f2bf(bf2f(BU[off]) * s * bf2f(SGB[off])); } }
}

__device__ __forceinline__ void sample_memattn(LAS unsigned char* lds, const Ptrs& P, int db, int h, int tid, int wid, int lane) {
    const unsigned char* ws = P.ws;
    const bf16* QC = (const bf16*)(ws + WS_QC); const bf16* SGC = (const bf16*)(ws + WS_SGC); bf16* ZC = (bf16*)(ws + WS_Z) + 2 * Z_STRIDE;
    const float* cmk = P.in[5]; const float* cmv = P.in[6];
    LAS float* qf = (LAS float*)lds; LAS float* sc = qf + 1024; LAS float* lsum = sc + 1024; LAS float* pacc = lsum + 16;
    for (int idx = tid; idx < 1024; idx += 512) { const int i = idx >> 8, d = idx & 255; qf[idx] = bf2f(QC[(size_t)(TP + db * 4 + i) * 1024 + h * 256 + d]); }
    __syncthreads();
    { const int m = tid & 255, th = tid >> 8; const float* kr = cmk + ((size_t)(db * 256 + m) * 4 + h) * 256; float d0 = 0.f, d1 = 0.f;
      for (int d = 0; d < 256; d += 4) { const f32x4 kv = *(const f32x4*)(kr + d); const f32x4 q0 = *(const LAS f32x4*)(qf + (2 * th) * 256 + d), q1 = *(const LAS f32x4*)(qf + (2 * th + 1) * 256 + d);
          d0 += (kv[0] * q0[0] + kv[1] * q0[1]) + (kv[2] * q0[2] + kv[3] * q0[3]); d1 += (kv[0] * q1[0] + kv[1] * q1[1]) + (kv[2] * q1[2] + kv[3] * q1[3]); }
      sc[(2 * th) * 256 + m] = d0; sc[(2 * th + 1) * 256 + m] = d1; }
    __syncthreads();
    if (wid < 4) { float v[4], mx = -__builtin_inff();
#pragma unroll
        for (int k = 0; k < 4; ++k) { v[k] = sc[wid * 256 + lane + 64 * k]; mx = fmaxf(mx, v[k]); }
        mx = wave_max(mx); float s = 0.f;
#pragma unroll
        for (int k = 0; k < 4; ++k) { v[k] = __builtin_amdgcn_exp2f(v[k] - mx); s += v[k]; sc[wid * 256 + lane + 64 * k] = v[k]; }
        s = wave_sum(s); if (lane == 0) lsum[wid] = s; }
    __syncthreads();
    { const int d = tid & 255, mh = tid >> 8; float a[4] = {0.f, 0.f, 0.f, 0.f};
      for (int m = 128 * mh; m < 128 * mh + 128; ++m) { const float v = cmv[((size_t)(db * 256 + m) * 4 + h) * 256 + d];
#pragma unroll
          for (int i = 0; i < 4; ++i) a[i] += sc[i * 256 + m] * v; }
#pragma unroll
      for (int i = 0; i < 4; ++i) pacc[(mh * 4 + i) * 256 + d] = a[i]; }
    __syncthreads();
    for (int idx = tid; idx < 1024; idx += 512) { const int i = idx >> 8, d = idx & 255; const size_t off = (size_t)(TP + db * 4 + i) * 1024 + h * 256 + d;
        ZC[off] = (bf16)f2bf((pacc[i * 256 + d] + pacc[(4 + i) * 256 + d]) / lsum[i] * bf2f(SGC[off])); }
    __syncthreads();
}

__device__ __forceinline__ void attnA_unit(LAS unsigned char* lds, LAS float* xch, const unsigned char* ws, int b, int g, int j, float M2, int tid, int wid, int lane) {
    const bf16* QB = (const bf16*)(ws + WS_QB); const bf16* KB = (const bf16*)(ws + WS_KB); const bf16* VB = (const bf16*)(ws + WS_VB); const bf16* SGA = (const bf16*)(ws + WS_SGA);
    const unsigned* MASK = (const unsigned*)(ws + WS_MASK); bf16* ZA = (bf16*)(ws + WS_Z);
    const int rg = wid & 3, par = wid >> 2, r32 = lane & 31, hi = lane >> 5;
    const int head = 2 * g + (rg >> 1); const size_t Rq = (size_t)b * 4096 + 64 * j + 32 * (rg & 1) + r32;
    const int nt = j + 1, nit = (nt + 1) >> 1;
    bf16x8 qr[8];
    { const bf16* qp = QB + Rq * 1024 + head * 128 + 8 * hi;
#pragma unroll
      for (int s = 0; s < 8; ++s) qr[s] = *(const bf16x8*)(qp + 16 * s); }
    const unsigned long long* mrow = (const unsigned long long*)(MASK + Rq * 128);
    unsigned long long mw_next = (par < nt) ? mrow[par] : 0ull;
    unsigned voffK[2], voffV[2];
#pragma unroll
    for (int i = 0; i < 2; ++i) { const int pc = 2 * wid + i;
        const int row = 4 * pc + (lane >> 4), chunk = (lane & 15) ^ (row & 7); voffK[i] = (unsigned)(row * 1024 + chunk * 16);
        const int sub = lane >> 5, kk = 8 * (pc >> 1) + ((lane & 31) >> 2), key = (kk & ~0xC) | ((kk & 4) << 1) | ((kk & 8) >> 1), c = 32 * (2 * (pc & 1) + sub) + 8 * (lane & 3);
        voffV[i] = (unsigned)(key * 1024 + c * 2);
        asm volatile("" : "+v"(voffK[i]), "+v"(voffV[i])); }
    const char* Kg = (const char*)(KB + (size_t)b * 4096 * 512 + g * 128); const char* Vg = (const char*)(VB + (size_t)b * 4096 * 512 + g * 128);
#define A_DMA(it_, bf_) do { _Pragma("unroll") for (int tl = 0; tl < 2; ++tl) { const int kt_ = 2 * (it_) + tl; if (kt_ < nt) { \
        const char* kb_ = Kg + (size_t)kt_ * 65536; const char* vb_ = Vg + (size_t)kt_ * 65536; \
        _Pragma("unroll") for (int i = 0; i < 2; ++i) { \
            __builtin_amdgcn_global_load_lds((const unsigned*)(kb_ + voffK[i]), (LAS unsigned*)(lds + (bf_) * 32768 + tl * 16384 + (2 * wid + i) * 1024), 16, 0, 0); \
            __builtin_amdgcn_global_load_lds((const unsigned*)(vb_ + voffV[i]), (LAS unsigned*)(lds + 65536 + (bf_) * 32768 + tl * 16384 + (2 * wid + i) * 1024), 16, 0, 0); } } } } while (0)
    f32x16 o[4];
#pragma unroll
    for (int d0 = 0; d0 < 4; ++d0) o[d0] = f32x16{};
    float l = 0.f;
    A_DMA(0, 0);
    asm volatile("s_waitcnt vmcnt(0)" ::: "memory"); __syncthreads();
    for (int it = 0; it < nit; ++it) {
        const int bf = it & 1; const int kt = 2 * it + par;
        const unsigned long long mw = mw_next;
        mw_next = (kt + 2 < nt) ? mrow[kt + 2] : 0ull;
        if (it + 1 < nit) A_DMA(it + 1, bf ^ 1);
#ifdef DBG_SERIAL_DMA
        asm volatile("s_waitcnt vmcnt(0)" ::: "memory"); __syncthreads();
#endif
        if (kt < nt) {
            const LAS unsigned char* kbase = lds + bf * 32768 + par * 16384; const LAS unsigned char* vp = lds + 65536 + bf * 32768 + par * 16384 + v_rd_base(lane);
            const int mlo = (int)((unsigned)mw >> (4 * hi)), mhi = (int)((unsigned)(mw >> 32) >> (4 * hi));
            f32x16 p0, p1;
#pragma unroll
            for (int r = 0; r < 16; ++r) { p0[r] = -M2; p1[r] = -M2; }
#pragma unroll
            for (int s = 0; s < 8; ++s) { const LAS unsigned char* a = kbase + KSWZ(r32, ((s & 3) * 16 + hi * 8) * 2) + (s >> 2) * 128;
                const bf16x8 b0 = *(const LAS bf16x8*)a, b1 = *(const LAS bf16x8*)(a + 32 * 256);
                p0 = __builtin_amdgcn_mfma_f32_32x32x16_bf16(b0, qr[s], p0, 0, 0, 0);
                p1 = __builtin_amdgcn_mfma_f32_32x32x16_bf16(b1, qr[s], p1, 0, 0, 0); }
#pragma unroll
            for (int r = 0; r < 16; ++r) { const int bit = (r & 3) + 8 * (r >> 2);
                const float e0 = __uint_as_float(__float_as_uint(__builtin_amdgcn_exp2f(p0[r])) & (unsigned)__builtin_amdgcn_sbfe(mlo, bit, 1));
                const float e1 = __uint_as_float(__float_as_uint(__builtin_amdgcn_exp2f(p1[r])) & (unsigned)__builtin_amdgcn_sbfe(mhi, bit, 1));
                p0[r] = e0; p1[r] = e1; l += e0 + e1; }
            bf16x8 pa[4];
            PK4(p0, 0, pa[0]); PK4(p0, 8, pa[1]); PK4(p1, 0, pa[2]); PK4(p1, 8, pa[3]);
#pragma unroll
            for (int d0 = 0; d0 < 4; ++d0)
#pragma unroll
                for (int ks = 0; ks < 4; ++ks) { const s16x4 lo = vtr(vp + d0 * 512 + ks * 4096), hh = vtr(vp + d0 * 512 + ks * 4096 + 2048);
                    o[d0] = __builtin_amdgcn_mfma_f32_32x32x16_bf16(pa[ks], VFRAG(lo, hh), o[d0], 0, 0, 0); }
        }
        asm volatile("s_waitcnt vmcnt(0)" ::: "memory"); __syncthreads();
    }
#undef A_DMA
    l += __shfl_xor(l, 32);
    LAS float* OM = (LAS float*)lds + rg * 4096; LAS float* LM = xch + rg * 32; LAS float* LM2 = xch + 128 + wid * 32;
    if (par == 1) {
#pragma unroll
        for (int d0 = 0; d0 < 4; ++d0)
#pragma unroll
            for (int r = 0; r < 16; ++r) OM[(d0 * 16 + r) * 64 + lane] = o[d0][r];
        if (hi == 0) LM[r32] = l;
    }
    __syncthreads();
    if (par == 0) {
        l += LM[r32];
        if (hi == 0) LM2[r32] = l;
        float rl[16];
#pragma unroll
        for (int r = 0; r < 16; ++r) rl[r] = 1.0f / LM2[crow(r, hi)];
#pragma unroll
        for (int d0 = 0; d0 < 4; ++d0)
#pragma unroll
            for (int r = 0; r < 16; ++r) { const size_t off = ((size_t)b * 4096 + 64 * j + 32 * (rg & 1) + crow(r, hi)) * 1024 + head * 128 + 32 * d0 + r32;
                const float val = (o[d0][r] + OM[(d0 * 16 + r) * 64 + lane]) * rl[r] * bf2f(SGA[off]);
                const float vn_ = __shfl_xor(val, 1);
                if ((r32 & 1) == 0) *(unsigned*)(ZA + off) = cvtpk(val, vn_); }
    }
    __syncthreads();
}

__device__ __forceinline__ float blk_sum(float v, LAS float* red, int wid, int lane) {
    v = wave_sum(v); if (lane == 0) red[wid] = v; __syncthreads();
    float s = 0.f;
#pragma unroll
    for (int k = 0; k < 8; ++k) s += red[k];
    __syncthreads(); return s;
}
__device__ __forceinline__ float blk_max(float v, LAS float* red, int wid, int lane) {
    v = wave_max(v); if (lane == 0) red[wid] = v; __syncthreads();
    float s = red[0];
#pragma unroll
    for (int k = 1; k < 8; ++k) s = fmaxf(s, red[k]);
    __syncthreads(); return s;
}
__device__ __forceinline__ int blk_isum(int v, LAS int* red, int wid, int lane) {
#pragma unroll
    for (int o = 1; o < 64; o <<= 1) v += __shfl_xor(v, o);
    if (lane == 0) red[wid] = v; __syncthreads();
    int s = 0;
#pragma unroll
    for (int k = 0; k < 8; ++k) s += red[k];
    __syncthreads(); return s;
}
__device__ __forceinline__ int blk_exscan(int v, LAS int* red, int wid, int lane) {
    int inc = v;
#pragma unroll
    for (int o = 1; o < 64; o <<= 1) { const int t = __shfl_up(inc, o); if (lane >= o) inc += t; }
    if (lane == 63) red[wid] = inc; __syncthreads();
    int base = 0;
#pragma unroll
    for (int k = 0; k < 8; ++k) if (k < wid) base += red[k];
    __syncthreads(); return base + inc - v;
}
__device__ __forceinline__ void sample_attn_unit(LAS unsigned char* lds, const Ptrs& P, int qi, int g, int tid, int wid, int lane) {
    const unsigned char* ws = P.ws;
    const float* SS = (const float*)(ws + WS_SS); const bf16* QB = (const bf16*)(ws + WS_QB); const bf16* SGA = (const bf16*)(ws + WS_SGA); bf16* ZA = (bf16*)(ws + WS_Z);
    const float* ck = P.in[2]; const float* cv = P.in[3]; const int* PT = (const int*)P.in[7];
    const int db = qi >> 2, ii = qi & 3; const size_t Rs = TP + qi;
    LAS float* redf = (LAS float*)lds; LAS int* redi = (LAS int*)(lds + 64); LAS int* sel = (LAS int*)(lds + 128);
    LAS float* qf = (LAS float*)(lds + 2048);    LAS float* pl = qf + 256;   LAS float* stat = pl + 512;   LAS float* pacc = stat + 16;
    const float NEG = -__builtin_inff();
    float v[33];
#pragma unroll
    for (int e = 0; e < 33; ++e) { const int key = 33 * tid + e; v[e] = (key < PAST + 4) ? SS[(size_t)qi * SS_LD + key] : NEG; }
    float mn = __builtin_inff(), mx = NEG;
#pragma unroll
    for (int e = 0; e < 33; ++e) { mx = fmaxf(mx, v[e]); mn = fminf(mn, v[e] == NEG ? __builtin_inff() : v[e]); }
    mx = blk_max(mx, redf, wid, lane); mn = -blk_max(-mn, redf, wid, lane);
    float lo = mn - (mx - mn) - 1.0f - fabsf(mn) * 1e-6f, hv = mx, thr = NEG, tv = 0.f; bool tie = false; int X = 0;
    for (int it = 0; it < 256; ++it) {
        const float mid = 0.5f * (lo + hv);
        if (!(mid > lo && mid < hv)) { tie = true; tv = hv; thr = hv; break; }
        int c = 0;
#pragma unroll
        for (int e = 0; e < 33; ++e) c += (v[e] > mid) ? 1 : 0;
        c = blk_isum(c, redi, wid, lane);
        if (c == TOPK) { thr = mid; break; }
        if (c > TOPK) lo = mid; else hv = mid;
    }
    int nsel = 0, ntie = 0;
#pragma unroll
    for (int e = 0; e < 33; ++e) { nsel += (v[e] > thr) ? 1 : 0; ntie += (tie && v[e] == tv) ? 1 : 0; }
    int tquota = 0;
    if (tie) { const int cgt = blk_isum(nsel, redi, wid, lane); const int need = TOPK - cgt; const int before = blk_exscan(ntie, redi, wid, lane);
        tquota = need - before; if (tquota < 0) tquota = 0; if (tquota > ntie) tquota = ntie; }
    (void)X;
    int pos = blk_exscan(nsel + tquota, redi, wid, lane);
    { int tq = tquota;
#pragma unroll
      for (int e = 0; e < 33; ++e) { bool s = v[e] > thr; if (!s && tie && v[e] == tv && tq > 0) { s = true; --tq; }
          if (s) { if (pos < TOPK) sel[pos] = 33 * tid + e; ++pos; } } }
    if (tid < 256) { const int hh = tid >> 7, d = tid & 127; qf[tid] = bf2f(QB[Rs * 1024 + (2 * g + hh) * 128 + d]); }
    __syncthreads();
    { const int k = tid & 255, hh = tid >> 8; const int idx = sel[k];
      const float* kr = (idx < PAST) ? ck + ((size_t)PT[db * 128 + (idx >> 7)] * 128 + (idx & 127)) * 512 + g * 128
                                     : P.out + O_KS + (size_t)(db * 4 + (idx - PAST)) * 512 + g * 128;
      float dsum = 0.f;
      for (int d = 0; d < 128; d += 4) { const f32x4 kv = *(const f32x4*)(kr + d); const f32x4 q = *(const LAS f32x4*)(qf + hh * 128 + d);
          dsum += (kv[0] * q[0] + kv[1] * q[1]) + (kv[2] * q[2] + kv[3] * q[3]); }
      pl[hh * 256 + k] = dsum; }
    __syncthreads();
    if (wid < 2) { float t[4], m_ = NEG;
#pragma unroll
        for (int k = 0; k < 4; ++k) { t[k] = pl[wid * 256 + lane + 64 * k]; m_ = fmaxf(m_, t[k]); }
        m_ = wave_max(m_); float s = 0.f;
#pragma unroll
        for (int k = 0; k < 4; ++k) { t[k] = __builtin_amdgcn_exp2f(t[k] - m_); s += t[k]; pl[wid * 256 + lane + 64 * k] = t[k]; }
        s = wave_sum(s); if (lane == 0) stat[wid] = s; }
    __syncthreads();
    { const int d = tid & 127, hh = (tid >> 7) & 1, kh = tid >> 8; float a = 0.f;
      for (int k = 128 * kh; k < 128 * kh + 128; ++k) { const int idx = sel[k];
          const float* vr = (idx < PAST) ? cv + ((size_t)PT[db * 128 + (idx >> 7)] * 128 + (idx & 127)) * 512 + g * 128
                                         : P.out + O_VS + (size_t)(db * 4 + (idx - PAST)) * 512 + g * 128;
          a += pl[hh * 256 + k] * vr[d]; }
      pacc[(kh * 2 + hh) * 128 + d] = a; }
    __syncthreads();
    if (tid < 256) { const int hh = tid >> 7, d = tid & 127; const size_t off = Rs * 1024 + (2 * g + hh) * 128 + d;
        ZA[off] = (bf16)f2bf((pacc[hh * 128 + d] + pacc[(2 + hh) * 128 + d]) / stat[hh] * bf2f(SGA[off])); }
    __syncthreads();
}
struct SchedTile {
    int bx, nbr;
    __device__ __forceinline__ bool next(int i, pg8::Unit& u) const {
        if (i >= nbr) return false;
        const int xcd = bx & 7, within = bx >> 3;
        u.pm = i * 33 + xcd * 4 + (within & 3); u.pn = i * 8 + (within >> 2); return true;
    }
    __device__ __forceinline__ void a_ready(const pg8::Unit&) const {}
    __device__ __forceinline__ void done(const pg8::Unit&) const {}
};
__device__ __forceinline__ void unpack8(v4u w, float (&f)[8]) {
    f[0] = __uint_as_float(w.x << 16); f[1] = __uint_as_float(w.x & 0xffff0000u); f[2] = __uint_as_float(w.y << 16); f[3] = __uint_as_float(w.y & 0xffff0000u);
    f[4] = __uint_as_float(w.z << 16); f[5] = __uint_as_float(w.z & 0xffff0000u); f[6] = __uint_as_float(w.w << 16); f[7] = __uint_as_float(w.w & 0xffff0000u);
}
struct EpiMerge {
    static constexpr bool PERM = true, AFTER_DRAIN = false;
    unsigned char* ws;
    __device__ __forceinline__ void operator()(const pg8::f32x4 (&acc)[2][2][4][2], const pg8::Unit& u, int wr, int wc, int fr, int fq) const {
        asm volatile("" : "+v"(fr), "+v"(fq));
        const int br = u.pn >> 3, pn = u.pn & 7, pm = u.pm - 33 * br;
        const bf16* Rg = (const bf16*)(ws + WS_R) + (size_t)br * R_STRIDE; float* M32 = (float*)(ws + WS_M32); bf16* MB = (bf16*)(ws + WS_MB);
#pragma unroll
        for (int ai = 0; ai < 2; ++ai)
#pragma unroll
            for (int m = 0; m < 4; ++m) { const size_t R = (size_t)(256 * pm + 128 * ai + 64 * wr + 16 * m + fr);
#pragma unroll
                for (int bj = 0; bj < 2; ++bj) { const size_t off = R * 2048 + 256 * pn + 128 * bj + 32 * wc + 8 * fq;
                    float gt[8]; unpack8(*(const v4u*)(Rg + off), gt);
                    pg8::f32x4 v0 = acc[ai][bj][m][0], v1 = acc[ai][bj][m][1];
#pragma unroll
                    for (int e = 0; e < 4; ++e) { v0[e] *= gt[e]; v1[e] *= gt[4 + e]; }
                    if (br > 0) { v0 += __builtin_nontemporal_load((const pg8::f32x4*)(M32 + off)); v1 += __builtin_nontemporal_load((const pg8::f32x4*)(M32 + off + 4)); }
                    if (br < 2) { *(pg8::f32x4*)(M32 + off) = v0; *(pg8::f32x4*)(M32 + off + 4) = v1; }
                    else *(v4u*)(MB + off) = (v4u){cvtpk(v0[0], v0[1]), cvtpk(v0[2], v0[3]), cvtpk(v1[0], v1[1]), cvtpk(v1[2], v1[3])}; } }
    }
};
struct EpiOut {
    static constexpr bool PERM = true, AFTER_DRAIN = false;
    const float* x; float* y;
    __device__ __forceinline__ void operator()(const pg8::f32x4 (&acc)[2][2][4][2], const pg8::Unit& u, int wr, int wc, int fr, int fq) const {
#pragma unroll
        for (int ai = 0; ai < 2; ++ai)
#pragma unroll
            for (int m = 0; m < 4; ++m) { const size_t R = (size_t)(256 * u.pm + 128 * ai + 64 * wr + 16 * m + fr);
#pragma unroll
                for (int bj = 0; bj < 2; ++bj) { const size_t off = R * 2048 + 256 * u.pn + 128 * bj + 32 * wc + 8 * fq;
                    *(pg8::f32x4*)(y + off) = *(const pg8::f32x4*)(x + off) + acc[ai][bj][m][0];
                    *(pg8::f32x4*)(y + off + 4) = *(const pg8::f32x4*)(x + off + 4) + acc[ai][bj][m][1]; } }
    }
};
__device__ __forceinline__ void sample_merge(LAS unsigned char* lds, const unsigned char* ws, int bx, int tid, int wid, int lane) {
    const bf16* Z = (const bf16*)(ws + WS_Z); const bf16* WP = (const bf16*)(ws + WS_WP); const bf16* Rg = (const bf16*)(ws + WS_R); bf16* MB = (bf16*)(ws + WS_MB);
    const int r32 = lane & 31, hi = lane >> 5, n0 = 8 * bx, col = n0 + (r32 & 7);
    f32x16 tot = {};
#pragma unroll
    for (int br = 0; br < 3; ++br) { f32x16 acc = {};
        const bf16* A = Z + (size_t)br * Z_STRIDE + (size_t)(TP + r32) * 1024 + wid * 128 + 8 * hi;
        const bf16* B = WP + ((size_t)br * 2048 + col) * 1024 + wid * 128 + 8 * hi;
#pragma unroll
        for (int s = 0; s < 8; ++s) acc = __builtin_amdgcn_mfma_f32_32x32x16_bf16(*(const bf16x8*)(A + 16 * s), *(const bf16x8*)(B + 16 * s), acc, 0, 0, 0);
#pragma unroll
        for (int r = 0; r < 16; ++r) tot[r] += bf2f(Rg[(size_t)br * R_STRIDE + (size_t)(TP + crow(r, hi)) * 2048 + col]) * acc[r]; }
    LAS float* red = (LAS float*)lds;
#pragma unroll
    for (int r = 0; r < 16; ++r) red[(wid * 16 + r) * 64 + lane] = tot[r];
    __syncthreads();
    if (tid < 256) { const int row = tid >> 3, c = tid & 7; const int h2 = (row >> 2) & 1, r = (row & 3) + 4 * (row >> 3), ln = c + 32 * h2; float s = 0.f;
#pragma unroll
        for (int w = 0; w < 8; ++w) s += red[(w * 16 + r) * 64 + ln];
        MB[(size_t)(TP + row) * 2048 + n0 + c] = (bf16)f2bf(s); }
    __syncthreads();
}
__device__ __forceinline__ void sample_out(LAS unsigned char* lds, const unsigned char* ws, const float* xs, float* ys, int bx, int tid, int wid, int lane) {
    const bf16* MB = (const bf16*)(ws + WS_MB); const bf16* WO = (const bf16*)(ws + WS_WOUT);
    const int r32 = lane & 31, hi = lane >> 5, n0 = 8 * bx, col = n0 + (r32 & 7);
    f32x16 acc = {};
    const bf16* A = MB + (size_t)(TP + r32) * 2048 + wid * 256 + 8 * hi; const bf16* B = WO + (size_t)col * 2048 + wid * 256 + 8 * hi;
#pragma unroll
    for (int s = 0; s < 16; ++s) acc = __builtin_amdgcn_mfma_f32_32x32x16_bf16(*(const bf16x8*)(A + 16 * s), *(const bf16x8*)(B + 16 * s), acc, 0, 0, 0);
    LAS float* red = (LAS float*)lds;
#pragma unroll
    for (int r = 0; r < 16; ++r) red[(wid * 16 + r) * 64 + lane] = acc[r];
    __syncthreads();
    if (tid < 256) { const int row = tid >> 3, c = tid & 7; const int h2 = (row >> 2) & 1, r = (row & 3) + 4 * (row >> 3), ln = c + 32 * h2; float s = 0.f;
#pragma unroll
        for (int w = 0; w < 8; ++w) s += red[(w * 16 + r) * 64 + ln];
        ys[(size_t)row * 2048 + n0 + c] = xs[(size_t)row * 2048 + n0 + c] + s; }
    __syncthreads();
}
#ifndef MK_N_LAUNCHES
#define MK_N_LAUNCHES 1
#endif
constexpr int N_PHASES = 6;
struct Args { const float* in[24]; float* out; unsigned char* ws; int ph_lo, ph_hi; };
__global__ void __launch_bounds__(512, 2) fwd_kernel(Args args) {
    extern __shared__ __attribute__((aligned(16))) unsigned char lds_raw[];
    LAS unsigned char* lds = (LAS unsigned char*)lds_raw;
    volatile LAS unsigned* MISC = (volatile LAS unsigned*)(lds + MISC_OFF);
    LAS float* xch = (LAS float*)(lds + XCH_OFF);
    const int tid = threadIdx.x, lane = tid & 63, wave = __builtin_amdgcn_readfirstlane(tid >> 6);
    const int G = gridDim.x, bx = blockIdx.x; const int vcu = (G % 8 == 0) ? (bx % 8) * (G / 8) + bx / 8 : bx;
    for (int u = tid; u < (LDS_BYTES - LDSCTL_OFF) / 4; u += 512) ((LAS unsigned*)(lds + LDSCTL_OFF))[u] = 0u;
    __syncthreads();
    unsigned char* ws = args.ws;
    gu32* ctl = (gu32*)(ws + WS_CTL);
    XcdBarrier bar; bar.bar = (unsigned*)(ctl + CW_BAR); bar.x = 0; bar.st = nullptr;
    if (MK_N_LAUNCHES == 1) bar = xcd_barrier_post((unsigned*)(ctl + CW_BAR), MISC + 8);
    Ptrs P;
#pragma unroll
    for (int i = 0; i < 24; ++i) P.in[i] = args.in[i];
    P.out = args.out; P.ws = ws;
    const int lo = args.ph_lo, hi_ = args.ph_hi;
#ifdef ONLY_PHASE
#define IN(k) ((k) == ONLY_PHASE && lo <= (k) && (k) < hi_)
#else
#define IN(k) (lo <= (k) && (k) < hi_)
#endif
#define SEAM(k) do { if (IN(k) && IN((k) + 1)) xcd_barrier(bar); } while (0)

    if (IN(0)) { p0_prologue(P, lds, vcu, G, wave, lane, tid); }
    SEAM(0);
    if (IN(1)) {
        pg8::Gemm g{(const pg8::bf16_t*)(ws + WS_XN), (const pg8::bf16_t*)(ws + WS_WIN), ROWS_A, NB_ALL, 2048};
        SchedIn S{G, bx};
        EpiIn E{P.out, ws, P.in[11], P.in[12], P.in[13], P.in[14], xch};
        pg8::gemm_phase<EpiIn, SchedIn, true, true>(lds, g, S, E);
    }
    SEAM(1);
    if (IN(2)) {
#ifndef P2_PARTS
#define P2_PARTS 63
#endif
        if (P2_PARTS & 1) { const int b = vcu >> 7, pp = vcu & 127;
          indexer_dispatch(lds, ws, b, 255 - pp, wave, lane);
          indexer_dispatch(lds, ws, b, pp, wave, lane); }
        __syncthreads();
        if (P2_PARTS & 2) {
#pragma unroll 1
        for (int k = 0; k < 2; ++k) { const int id = 2 * vcu + k; chunkmix_unit(lds, P, id >> 3, id & 7, tid, wave, lane); } }
        if (P2_PARTS & 4) { const float M2c = logit_bound(P.in[13], P.in[14], 256, lane);
          memattn_unit(lds, xch, P, vcu >> 7, (vcu >> 5) & 3, vcu & 31, M2c, tid, wave, lane); }
        if (P2_PARTS & 8) { const int db = vcu >> 5, ww = (vcu & 31) * 8 + wave; sample_scores_unit(P, db, ww & 1, ww >> 1, lane); }
        if (P2_PARTS & 16) { if (vcu < 8) sample_chunkmix(P, vcu, tid); }
        if (P2_PARTS & 32) { if (vcu >= 32 && vcu < 64) sample_memattn(lds, P, (vcu - 32) >> 2, (vcu - 32) & 3, tid, wave, lane); }
    }
    SEAM(2);
    if (IN(3)) {
        const float M2a = logit_bound(P.in[11], P.in[12], 128, lane);
        const int b = vcu >> 7, g = (vcu >> 5) & 3, jp = vcu & 31;
#ifndef P3_PARTS
#define P3_PARTS 3
#endif
        if (P3_PARTS & 1) {
#pragma unroll 1
        for (int k = 0; k < 2; ++k) attnA_unit(lds, xch, ws, b, g, k == 0 ? 63 - jp : jp, M2a, tid, wave, lane); }
        if (P3_PARTS & 2) { if (vcu < 128) sample_attn_unit(lds, P, vcu >> 2, vcu & 3, tid, wave, lane); }
    }
    SEAM(3);
    if (IN(4)) {
        pg8::Gemm g{(const pg8::bf16_t*)(ws + WS_Z), (const pg8::bf16_t*)(ws + WS_WP), 3 * ROWS_T, 3 * 2048, 1024};
        SchedTile S{bx, 3};
        EpiMerge E{ws};
        pg8::gemm_phase<EpiMerge, SchedTile, true, true>(lds, g, S, E);
        sample_merge(lds, ws, bx, tid, wave, lane);
    }
    SEAM(4);
    if (IN(5)) {
        pg8::Gemm g{(const pg8::bf16_t*)(ws + WS_MB), (const pg8::bf16_t*)(ws + WS_WOUT), TP, 2048, 2048};
        SchedTile S{bx, 1};
        EpiOut E{P.in[0], P.out + O_YP};
        pg8::gemm_phase<EpiOut, SchedTile, true, true>(lds, g, S, E);
        sample_out(lds, ws, P.in[1], P.out + O_YS, bx, tid, wave, lane);
    }
#undef IN
#undef SEAM
}

extern "C" void kernel_launch(void* const* d_in, const int* in_sizes, int n_in, void* d_out, int out_size, void* d_ws, size_t ws_size, hipStream_t stream) {
    static int grid = 0;
    if (grid == 0) {
        if (n_in != 24 || (size_t)out_size != O_TOTAL || ws_size < WS_END) { fprintf(stderr, "kernel_launch: unexpected shapes: n_in %d out_size %d ws %zu\n", n_in, out_size, ws_size); grid = -1; return; }
        int dev = 0, cus = 0;
        if (hipGetDevice(&dev) != hipSuccess || hipDeviceGetAttribute(&cus, hipDeviceAttributeMultiprocessorCount, dev) != hipSuccess) { grid = -1; return; }
        if (hipFuncSetAttribute((const void*)fwd_kernel, hipFuncAttributeMaxDynamicSharedMemorySize, LDS_BYTES) != hipSuccess) { fprintf(stderr, "kernel_launch: hipFuncSetAttribute failed\n"); grid = -1; return; }
        int per_cu = 0;
        if (hipOccupancyMaxActiveBlocksPerMultiprocessor(&per_cu, (const void*)fwd_kernel, 512, LDS_BYTES) != hipSuccess || per_cu < 1) fprintf(stderr, "kernel_launch: occupancy query says %d\n", per_cu);
        (void)hipGetLastError();
        grid = cus;
        if (grid != 256) fprintf(stderr, "kernel_launch: built for a 256-CU device, got %d\n", grid);
    }
    if (grid < 0) return;
    (void)hipMemsetAsync((char*)d_ws + WS_CTL, 0, CTL_ZERO_BYTES, stream);
    Args a{};
    for (int i = 0; i < 24; ++i) a.in[i] = (const float*)d_in[i];
    a.out = (float*)d_out; a.ws = (unsigned char*)d_ws;
#if MK_N_LAUNCHES == 1
    a.ph_lo = 0; a.ph_hi = N_PHASES;
    hipLaunchKernelGGL(fwd_kernel, dim3(grid), dim3(512), LDS_BYTES, stream, a);
#else
    for (int p = 0; p < N_PHASES; ++p) { a.ph_lo = p; a.ph_hi = p + 1; hipLaunchKernelGGL(fwd_kernel, dim3(grid), dim3(512), LDS_BYTES, stream, a); }
#endif
}
```

```cpp
#include <hip/hip_runtime.h>
#include <cstdio>
#include <cstdint>
#include <cmath>

namespace pg8 {
#define PG8_LAS __attribute__((address_space(3)))
typedef unsigned short bf16_t;
typedef short bf16x8 __attribute__((ext_vector_type(8)));
typedef float f32x4 __attribute__((ext_vector_type(4)));
typedef unsigned u32x4 __attribute__((ext_vector_type(4)));
constexpr int BM = 256, BK = 64, HALF = 128, HTB = HALF * BK * 2  , STAGE_BYTES = 8 * HTB, NXCD = 8, WGM = 8;

__host__ __device__ __forceinline__ int lds_byte(int r, int c) { const int st = (r >> 4) * 2 + (c >> 5), rr = r & 15, cc = c & 31, ob = rr * 64 + cc * 2; return st * 1024 + (ob ^ (((ob >> 9) & 1) << 5)); }
__host__ __device__ __forceinline__ void stage_rc(int b, int& R, int& C) { const int st = b / 1024, sb = b % 1024, swz = sb ^ (((sb >> 9) & 1) << 5); R = (st >> 1) * 16 + swz / 64; C = (st & 1) * 32 + (swz % 64) / 2; }
__host__ __device__ __forceinline__ int perm32(int rho) { const int n = rho >> 4, i = rho & 15; return 8 * (i >> 2) + 4 * n + (i & 3); }

struct Unit { int pm, pn; };
struct Gemm { const bf16_t* A; const bf16_t* Bt; int M, N, K; };

__device__ __forceinline__ unsigned cvt_pk_bf16(float lo, float hi) { unsigned r; asm volatile("v_cvt_pk_bf16_f32 %0, %1, %2" : "=v"(r) : "v"(lo), "v"(hi)); return r; }
typedef float f32x2 __attribute__((ext_vector_type(2)));
template <class Epi, class Sched, bool ALIGN_EPI = false, bool SP2 = false>
__device__ __forceinline__ void gemm_phase(PG8_LAS unsigned char* lds, const Gemm g, const Sched& S, const Epi& E) {
    const int tid = threadIdx.x, wid = __builtin_amdgcn_readfirstlane(tid >> 6), lane = tid & 63, wr = wid >> 2, wc = wid & 3, fr = lane & 15, fq = lane >> 4;
    const int K = g.K, nt = K / BK;
    unsigned voffA[2], voffB[2];
#pragma unroll
    for (int i = 0; i < 2; ++i) { int R, C; stage_rc(tid * 16 + i * 8192, R, C); const int Rb = Epi::PERM ? ((R & ~31) + perm32(R & 31)) : R;
        voffA[i] = (unsigned)(R * K + C) * 2u; voffB[i] = (unsigned)(Rb * K + C) * 2u; }
    const size_t kstep = (size_t)(BK * 2);
    const size_t hstep = (size_t)HALF * K * 2;
    const size_t tstep = 2 * hstep;
    const unsigned ldsw = (unsigned)wid * 1024u;
    const int aoff = lds_byte(wr * 64 + fr, fq * 8), boff = lds_byte(wc * 32 + fr, fq * 8);
#define PG8_SA(b, h) (((b) * 2 + (h)) * HTB)
#define PG8_SB(b, h) ((4 + (b) * 2 + (h)) * HTB)
#define PG8_STAGE(bufoff, gbase, voff) do { _Pragma("unroll") for (int _i = 0; _i < 2; ++_i) \
        __builtin_amdgcn_global_load_lds((const unsigned*)((const char*)(gbase) + (voff)[_i]), (PG8_LAS unsigned*)(lds + (bufoff) + ldsw + _i * 8192), 16, 0, 0); } while (0)
#define PG8_LDA(dst, b, h) do { _Pragma("unroll") for (int m = 0; m < 4; ++m) _Pragma("unroll") for (int k = 0; k < 2; ++k) dst[m][k] = *(const PG8_LAS bf16x8*)(lds + PG8_SA(b, h) + aoff + m * 2048 + k * 1024); } while (0)
#define PG8_LDB(dst, b, h) do { _Pragma("unroll") for (int n = 0; n < 2; ++n) _Pragma("unroll") for (int k = 0; k < 2; ++k) dst[n][k] = *(const PG8_LAS bf16x8*)(lds + PG8_SB(b, h) + boff + n * 2048 + k * 1024); } while (0)
#define PG8_MMA(ai, bj, At, Bt) do { __builtin_amdgcn_s_setprio(1); _Pragma("unroll") for (int m = 0; m < 4; ++m) _Pragma("unroll") for (int n = 0; n < 2; ++n) _Pragma("unroll") for (int k = 0; k < 2; ++k) \
        acc[ai][bj][m][n] = __builtin_amdgcn_mfma_f32_16x16x32_bf16(Bt[n][k], At[m][k], acc[ai][bj][m][n], 0, 0, 0); __builtin_amdgcn_s_setprio(0); } while (0)
#define PG8_WAIT_V(n) asm volatile("s_waitcnt vmcnt(" #n ")" ::: "memory")
#define PG8_WAIT_L(n) asm volatile("s_waitcnt lgkmcnt(" #n ")" ::: "memory")
#define PG8_BAR __builtin_amdgcn_s_barrier()
#define PG8_SCHED __builtin_amdgcn_sched_barrier(0)
    Unit cur, nxt; int ui = 0;
    if (!S.next(0, cur)) return;
    f32x4 acc[2][2][4][2];
#pragma unroll
    for (int a = 0; a < 2; ++a)
#pragma unroll
        for (int b = 0; b < 2; ++b)
#pragma unroll
            for (int m = 0; m < 4; ++m)
#pragma unroll
                for (int n = 0; n < 2; ++n) acc[a][b][m][n] = (f32x4){0.f, 0.f, 0.f, 0.f};
    bf16x8 At[4][2], B0[2][2], B1[2][2];
    const char* cA = (const char*)g.A + (size_t)cur.pm * tstep; const char* cB = (const char*)g.Bt + (size_t)cur.pn * tstep;
    S.a_ready(cur);
    if constexpr (SP2) {
        PG8_STAGE(PG8_SB(0, 0), cB, voffB); PG8_STAGE(PG8_SB(0, 1), cB + hstep, voffB); PG8_STAGE(PG8_SA(0, 0), cA, voffA); PG8_STAGE(PG8_SA(0, 1), cA + hstep, voffA);
        if (wr == 1) PG8_BAR;
        PG8_WAIT_V(2); PG8_BAR;
        PG8_STAGE(PG8_SB(1, 0), cB + kstep, voffB); PG8_STAGE(PG8_SA(1, 0), cA + kstep, voffA); PG8_STAGE(PG8_SB(1, 1), cB + hstep + kstep, voffB);
        PG8_WAIT_V(6); PG8_BAR;
    } else {
        PG8_STAGE(PG8_SB(0, 0), cB, voffB); PG8_STAGE(PG8_SA(0, 0), cA, voffA); PG8_STAGE(PG8_SB(0, 1), cB + hstep, voffB); PG8_STAGE(PG8_SA(0, 1), cA + hstep, voffA);
        if (wr == 1) PG8_BAR;
        PG8_WAIT_V(4); PG8_BAR;
        PG8_STAGE(PG8_SB(1, 0), cB + kstep, voffB); PG8_STAGE(PG8_SA(1, 0), cA + kstep, voffA); PG8_STAGE(PG8_SB(1, 1), cB + hstep + kstep, voffB);
        PG8_WAIT_V(6); PG8_BAR;
    }
    for (;;) {
        const bool has_next = S.next(ui + 1, nxt);
        const char* nA = has_next ? (const char*)g.A + (size_t)nxt.pm * tstep : cA; const char* nB = has_next ? (const char*)g.Bt + (size_t)nxt.pn * tstep : cB;
        for (int t = 0; t < nt; t += 2) {
            const bool last = (t == nt - 2);
            const char* a1 = cA + (size_t)(t + 1) * kstep;
            const char* a2 = last ? nA : cA + (size_t)(t + 2) * kstep; const char* b2 = last ? nB : cB + (size_t)(t + 2) * kstep;
            const char* a3 = a2 + kstep; const char* b3 = b2 + kstep;
            if (last && has_next) S.a_ready(nxt);
            if constexpr (SP2) {
            PG8_LDB(B0, 0, 0); PG8_LDB(B1, 0, 1); PG8_SCHED; PG8_LDA(At, 0, 0); PG8_STAGE(PG8_SA(1, 1), a1 + hstep, voffA);
            PG8_WAIT_V(8); PG8_WAIT_L(0); PG8_BAR; PG8_MMA(0, 0, At, B0); PG8_MMA(0, 1, At, B1); PG8_BAR; PG8_SCHED;
            PG8_LDA(At, 0, 1); PG8_STAGE(PG8_SB(0, 0), b2, voffB); PG8_STAGE(PG8_SB(0, 1), b2 + hstep, voffB); PG8_STAGE(PG8_SA(0, 0), a2, voffA);
            PG8_WAIT_V(8); PG8_WAIT_L(0); PG8_BAR; PG8_MMA(1, 0, At, B0); PG8_MMA(1, 1, At, B1); PG8_BAR; PG8_SCHED;
            PG8_LDB(B0, 1, 0); PG8_LDB(B1, 1, 1); PG8_SCHED; PG8_LDA(At, 1, 0); PG8_STAGE(PG8_SA(0, 1), a2 + hstep, voffA);
            PG8_WAIT_V(8); PG8_WAIT_L(0); PG8_BAR; PG8_MMA(0, 0, At, B0); PG8_MMA(0, 1, At, B1); PG8_BAR; PG8_SCHED;
            PG8_LDA(At, 1, 1); PG8_STAGE(PG8_SB(1, 0), b3, voffB); PG8_STAGE(PG8_SB(1, 1), b3 + hstep, voffB); PG8_STAGE(PG8_SA(1, 0), a3, voffA);
            PG8_WAIT_V(8); PG8_WAIT_L(0); PG8_BAR; PG8_MMA(1, 0, At, B0); PG8_MMA(1, 1, At, B1); PG8_BAR; PG8_SCHED;
            } else {
            PG8_LDB(B0, 0, 0); PG8_SCHED; PG8_LDA(At, 0, 0); PG8_STAGE(PG8_SA(1, 1), a1 + hstep, voffA);
            PG8_WAIT_L(8); PG8_BAR; PG8_WAIT_L(0); PG8_MMA(0, 0, At, B0); PG8_BAR; PG8_SCHED;
            PG8_LDB(B1, 0, 1); PG8_STAGE(PG8_SB(0, 0), b2, voffB);
            PG8_BAR; PG8_WAIT_L(0); PG8_MMA(0, 1, At, B1); PG8_BAR;
            PG8_LDA(At, 0, 1); PG8_STAGE(PG8_SA(0, 0), a2, voffA);
            PG8_BAR; PG8_WAIT_L(0); PG8_MMA(1, 0, At, B0); PG8_BAR; PG8_SCHED;
            PG8_STAGE(PG8_SB(0, 1), b2 + hstep, voffB);
            PG8_WAIT_V(6); PG8_BAR; PG8_MMA(1, 1, At, B1); PG8_BAR;
            PG8_LDB(B0, 1, 0); PG8_SCHED; PG8_LDA(At, 1, 0); PG8_STAGE(PG8_SA(0, 1), a2 + hstep, voffA);
            PG8_WAIT_L(8); PG8_BAR; PG8_WAIT_L(0); PG8_MMA(0, 0, At, B0); PG8_BAR; PG8_SCHED;
            PG8_LDB(B1, 1, 1); PG8_STAGE(PG8_SB(1, 0), b3, voffB);
            PG8_BAR; PG8_WAIT_L(0); PG8_MMA(0, 1, At, B1); PG8_BAR;
            PG8_LDA(At, 1, 1); PG8_STAGE(PG8_SA(1, 0), a3, voffA);
            PG8_BAR; PG8_WAIT_L(0); PG8_MMA(1, 0, At, B0); PG8_BAR; PG8_SCHED;
            PG8_STAGE(PG8_SB(1, 1), b3 + hstep, voffB);
            PG8_WAIT_V(6); PG8_BAR; PG8_MMA(1, 1, At, B1); PG8_BAR;
            }
        }
        if constexpr (ALIGN_EPI) { if (wr == 0) PG8_BAR; }
        if constexpr (!Epi::AFTER_DRAIN) { E(acc, cur, wr, wc, fr, fq); S.done(cur); }
        if (!has_next) break;
        if constexpr (!Epi::KEEP_ACC) {
#pragma unroll
        for (int a = 0; a < 2; ++a)
#pragma unroll
            for (int b = 0; b < 2; ++b)
#pragma unroll
                for (int m = 0; m < 4; ++m)
#pragma unroll
                    for (int n = 0; n < 2; ++n) acc[a][b][m][n] = (f32x4){0.f, 0.f, 0.f, 0.f};
        }
        cur = nxt; cA = nA; cB = nB; ++ui;
        if constexpr (ALIGN_EPI) { if (wr == 1) PG8_BAR; }
    }
    PG8_WAIT_V(0);
    if constexpr (!ALIGN_EPI) { if (wr == 0) PG8_BAR; }
    PG8_BAR;
    if constexpr (Epi::AFTER_DRAIN) { E.fused(acc, cur, wr, wc, fr, fq, lds, wid, lane); S.done(cur); }
#undef PG8_SA
#undef PG8_SB
#undef PG8_STAGE
#undef PG8_LDA
#undef PG8_LDB
#undef PG8_MMA
#undef PG8_WAIT_V
#undef PG8_WAIT_L
#undef PG8_BAR
#undef PG8_SCHED
}
}

constexpr int DM = 2048, TP = 8192, SEQ = 4096, TS = 32, PAST = 16384;
constexpr int ROWS_T = 8448;
constexpr int ROWS_A = 8960;
constexpr int D_IN = 15440, NPAD = 15616;
constexpr int NB_ALL = NPAD + 2048;
constexpr int TOPK = 256;
constexpr float EPS = 1e-6f;
constexpr float LOG2E = 1.4426950408889634f;
constexpr float QS_A = 0.08838834764831845f * LOG2E;
constexpr float QS_C = 0.0625f * LOG2E;

constexpr size_t O_YP = 0, O_YS = 16777216, O_KP = 16842752, O_VP = 21037056, O_KIP = 25231360, O_MKP = 25755648, O_MVP = 26279936,
                 O_KS = 26804224, O_VS = 26820608, O_KIS = 26836992, O_CVS = 26839040, O_TOTAL = 26871808;

constexpr size_t MiB = 1u << 20;
constexpr size_t WS_CTL = 0, CTL_ZERO_BYTES = 1 * MiB;
constexpr size_t WS_WIN = 2 * MiB;
constexpr size_t WS_WP = 72 * MiB;
constexpr size_t WS_WOUT = 84 * MiB;
constexpr size_t WS_WST = 92 * MiB;
constexpr size_t WS_CS = 93 * MiB;
constexpr size_t WS_XN = 97 * MiB;
constexpr size_t WS_QB = 132 * MiB;
constexpr size_t WS_KB = 149 * MiB;
constexpr size_t WS_VB = 158 * MiB;
constexpr size_t WS_QI = 167 * MiB;
constexpr size_t WS_KI = 184 * MiB;
constexpr size_t WS_WI = 186 * MiB;
constexpr size_t WS_SGA = 187 * MiB;
constexpr size_t WS_SGB = 204 * MiB;
constexpr size_t WS_SGC = 221 * MiB;
constexpr size_t WS_BU = 238 * MiB;
constexpr size_t WS_BV = 255 * MiB;
constexpr size_t WS_SSQ = 288 * MiB;
constexpr size_t WS_QC = 289 * MiB;
constexpr size_t WS_R = 306 * MiB;
constexpr size_t R_STRIDE = (size_t)ROWS_T * 2048;
constexpr size_t WS_MK = 405 * MiB;
constexpr size_t WS_MV = 406 * MiB;
constexpr size_t WS_MASK = 407 * MiB;
constexpr size_t WS_SS = 411 * MiB;
constexpr int SS_LD = 16512;
constexpr size_t WS_Z = 414 * MiB;
constexpr size_t Z_STRIDE = (size_t)ROWS_T * 1024;
constexpr size_t WS_M32 = 464 * MiB;
constexpr size_t WS_MB = 528 * MiB;
constexpr size_t WS_END = 562 * MiB;
static_assert(WS_WIN + (size_t)NB_ALL * 2048 * 2 <= WS_WP && WS_XN + (size_t)ROWS_A * 2048 * 2 <= WS_QB && WS_BV + (size_t)ROWS_T * 1024 * 4 <= WS_SSQ, "ws map");
static_assert(WS_R + 3 * R_STRIDE * 2 <= WS_MK && WS_Z + 3 * Z_STRIDE * 2 <= WS_M32 && WS_M32 + (size_t)TP * 2048 * 4 <= WS_MB && WS_MB + (size_t)ROWS_T * 2048 * 2 <= WS_END, "ws map 2");
static_assert(WS_CS + (size_t)4100 * 96 * 8 <= WS_XN && WS_SS + (size_t)32 * SS_LD * 4 <= WS_Z, "ws map 3");

constexpr int CW_BAR = 4096;

constexpr int RING_BYTES = 131072;
constexpr int XCH_OFF = RING_BYTES;
constexpr int LDSCTL_OFF = RING_BYTES + 16384;
constexpr int MISC_OFF = LDSCTL_OFF + 320;
constexpr int LDS_BYTES = 163840;

#define GAS __attribute__((address_space(1)))
#define LAS __attribute__((address_space(3)))
typedef unsigned short bf16;
typedef unsigned v4u __attribute__((ext_vector_type(4)));
typedef float f32x4 __attribute__((ext_vector_type(4)));
typedef short bf16x8 __attribute__((ext_vector_type(8)));
typedef GAS unsigned gu32;
typedef GAS unsigned long long gu64;
#define RLX_AGENT __ATOMIC_RELAXED, __HIP_MEMORY_SCOPE_AGENT
#define LDS_WAIT() asm volatile("s_waitcnt lgkmcnt(0)" ::: "memory")
#define VM_WAIT() asm volatile("s_waitcnt vmcnt(0)" ::: "memory")
__device__ __forceinline__ unsigned long long rt() { return __builtin_amdgcn_s_memrealtime(); }
__device__ __forceinline__ unsigned f2bf(float f) { unsigned u = __builtin_bit_cast(unsigned, f); return (u + 0x7fffu + ((u >> 16) & 1u)) >> 16; }
__device__ __forceinline__ unsigned pk2(float lo, float hi) { return f2bf(lo) | (f2bf(hi) << 16); }

#define XB_TMO      128
#define XB_XCNT(j)  (256  + 64 * (j))
#define XB_XSUB(j)  (1280 + 64 * (j))
#define XB_XGEN(j)  (2304 + 64 * (j))
#define XB_TOP      3328
#define XB_TOPGEN   3392
#define XCD_BAR_WORDS 3456
#define XB_SPIN_CAP (1u << 18)

__device__ __forceinline__ unsigned xb_ld(unsigned* p)              { return __hip_atomic_load(p, __ATOMIC_RELAXED, __HIP_MEMORY_SCOPE_AGENT); }
__device__ __forceinline__ unsigned xb_add(unsigned* p, unsigned v) { return __hip_atomic_fetch_add(p, v, __ATOMIC_RELAXED, __HIP_MEMORY_SCOPE_AGENT); }
__device__ __forceinline__ unsigned xb_xcc_id() { return (unsigned)__builtin_amdgcn_s_getreg((3 << 11) | 20) & 0xFu; }
#define XB_SPIN(cond, bar) do { unsigned _sp = 0; while (cond) { __builtin_amdgcn_s_sleep(1); \
    if ((++_sp & 255u) == 0u) { if (xb_ld(&(bar)[XB_TMO])) break; if (_sp > XB_SPIN_CAP) { atomicAdd(&(bar)[XB_TMO], 1u); break; } } } } while (0)

struct XcdBarrier {
    unsigned* bar; unsigned x;
    volatile LAS unsigned* st;
};

__device__ __forceinline__ XcdBarrier xcd_barrier_post(unsigned* bar, volatile LAS unsigned* st) {
    XcdBarrier b; b.bar = bar; b.x = xb_xcc_id(); b.st = st;
    if (threadIdx.x == 0) (void)xb_add(&bar[XB_XCNT(b.x)], 1u);
    return b;
}
__device__ __forceinline__ void xcd_barrier_complete(unsigned* bar, unsigned x, unsigned& nloc, unsigned& nx) {
    const unsigned G = gridDim.x * gridDim.y * gridDim.z;
    unsigned sum, cnt, mine, sp = 0u;
    for (;;) {
        sum = 0u; cnt = 0u; mine = 0u;
#pragma unroll
        for (unsigned j = 0; j < 16; ++j) { const unsigned c = xb_ld(&bar[XB_XCNT(j)]); sum += c; cnt += (c > 0u) ? 1u : 0u; mine = (j == x) ? c : mine; }
        if (sum == G) break;
        __builtin_amdgcn_s_sleep(1);
        if ((++sp & 255u) == 0u) { if (xb_ld(&bar[XB_TMO])) break; if (sp > XB_SPIN_CAP) { atomicAdd(&bar[XB_TMO], 1u); break; } }
    }
    nloc = mine > 0u ? mine : 1u; nx = cnt > 0u ? cnt : 1u;
}

__device__ __forceinline__ void xcd_barrier(const XcdBarrier& b) {
    asm volatile("s_waitcnt vmcnt(0)" ::: "memory");
    __syncthreads();
    if (threadIdx.x == 0) {
        unsigned* bar = b.bar;
        __builtin_amdgcn_s_waitcnt(0);
        unsigned nloc = b.st[0], nx = b.st[1];
        if (nloc == 0u) { xcd_barrier_complete(bar, b.x, nloc, nx); b.st[0] = nloc; b.st[1] = nx; }
        const unsigned old = xb_add(&bar[XB_XSUB(b.x)], 1u);
        const unsigned gen = old / nloc;
        if (old + 1u == (gen + 1u) * nloc) {
            __builtin_amdgcn_fence(__ATOMIC_RELEASE, "agent");
            asm volatile("s_waitcnt vmcnt(0)" ::: "memory");
            const unsigned og = xb_add(&bar[XB_TOP], 1u);
            const unsigned tg = og / nx;
            if (og + 1u == (tg + 1u) * nx) xb_add(&bar[XB_TOPGEN], 1u);
            else XB_SPIN(xb_ld(&bar[XB_TOPGEN]) == tg, bar);
            __builtin_amdgcn_fence(__ATOMIC_ACQUIRE, "agent");
            xb_add(&bar[XB_XGEN(b.x)], 1u);
            asm volatile("s_waitcnt vmcnt(0)" ::: "memory");
        } else {
            XB_SPIN(xb_ld(&bar[XB_XGEN(b.x)]) == gen, bar);
            __builtin_amdgcn_fence(__ATOMIC_ACQUIRE, "agent");
            asm volatile("s_waitcnt vmcnt(0)" ::: "memory");
        }
    }
    __syncthreads();
}

typedef _Float16 h8 __attribute__((ext_vector_type(8)));
typedef _Float16 h4 __attribute__((ext_vector_type(4)));
typedef _Float16 h2v __attribute__((ext_vector_type(2)));
typedef float f32x16 __attribute__((ext_vector_type(16)));
typedef float f32x2 __attribute__((ext_vector_type(2)));
typedef short s16x4 __attribute__((ext_vector_type(4)));
typedef unsigned u32x2 __attribute__((ext_vector_type(2)));
typedef __bf16 bf16x2_t __attribute__((ext_vector_type(2)));

__device__ __forceinline__ unsigned cvtpk(float lo, float hi) { f32x2 v = {lo, hi}; bf16x2_t b = __builtin_convertvector(v, bf16x2_t); return __builtin_bit_cast(unsigned, b); }
__device__ __forceinline__ unsigned cvtpk_h(float lo, float hi) { f32x2 v = {lo, hi}; h2v b = __builtin_convertvector(v, h2v); return __builtin_bit_cast(unsigned, b); }
__device__ __forceinline__ float bf2f(unsigned short h) { return __uint_as_float((unsigned)h << 16); }
__device__ __forceinline__ float sigmoidf_(float x) { return __builtin_amdgcn_rcpf(1.0f + __builtin_amdgcn_exp2f(-x * LOG2E)); }
__device__ __forceinline__ float siluf_(float x) { return x * sigmoidf_(x); }
__device__ __forceinline__ int crow(int r, int hi) { return (r & 3) + 8 * (r >> 2) + 4 * hi; }
#define BAR_LDS() do { asm volatile("s_waitcnt lgkmcnt(0)" ::: "memory"); __builtin_amdgcn_s_barrier(); asm volatile("" ::: "memory"); } while (0)

struct Ptrs {
    const float* in[24]; float* out; unsigned char* ws;
};

__device__ __forceinline__ int rope128_pos(int d) { const int s = d >> 6, dd = d & 63; return 8 * (dd >> 2) + 4 * s + (dd & 3); }
__device__ __forceinline__ int rope64_pos(int d) { const int n = d >> 5, dd = d & 31; return 32 * (dd >> 4) + 8 * ((dd >> 2) & 3) + 4 * n + (dd & 3); }
__device__ __forceinline__ int win_dst_row(int n) {
    if (n < 1024) return (n & ~127) + rope128_pos(n & 127);
    if (n < 1536) { const int j = n - 1024; return 1024 + (j & ~127) + rope128_pos(j & 127); }
    if (n < 2048) return n;
    if (n < 3072) { const int j = n - 2048; return 2048 + (j & ~63) + rope64_pos(j & 63); }
    if (n < 3136) return 15360 + rope64_pos(n - 3072);
    if (n < 3152) return 15424 + (n - 3136);
    return n - 80;
}
template <int MODE>
__device__ __forceinline__ void p0_transpose_item(const float* W, int K, int N, bf16* WT, int row_off, LAS unsigned char* scr, int item, int lane) {
    const int nblk = (N + 63) / 64, kb = item / nblk, nb = item % nblk, k0 = 64 * kb, n0 = 64 * nb;
    const int q = lane >> 4, c = lane & 15, nl = n0 + 4 * c;
    f32x4 v[16];
    const float* src = W + (size_t)(k0 + 16 * q) * N + nl;
    if (nl < N) {
#pragma unroll
        for (int i = 0; i < 16; ++i) v[i] = *(const GAS f32x4*)(src + (size_t)i * N);
    } else {
#pragma unroll
        for (int i = 0; i < 16; ++i) v[i] = (f32x4){0.f, 0.f, 0.f, 0.f};
    }
#pragma unroll
    for (int e = 0; e < 4; ++e) {
        v4u lo, hi; lo.x = pk2(v[0][e], v[1][e]); lo.y = pk2(v[2][e], v[3][e]); lo.z = pk2(v[4][e], v[5][e]); lo.w = pk2(v[6][e], v[7][e]);
        hi.x = pk2(v[8][e], v[9][e]); hi.y = pk2(v[10][e], v[11][e]); hi.z = pk2(v[12][e], v[13][e]); hi.w = pk2(v[14][e], v[15][e]);
        *(LAS v4u*)(scr + (4 * c + e) * 144 + 32 * q) = lo; *(LAS v4u*)(scr + (4 * c + e) * 144 + 32 * q + 16) = hi; }
    LDS_WAIT(); asm volatile("" ::: "memory");
#pragma unroll
    for (int j = 0; j < 8; ++j) { const int n = (lane >> 3) + 8 * j, ch = lane & 7;
        const v4u o = *(const LAS v4u*)(scr + n * 144 + ch * 16);
        if (n0 + n < N) { const int row = MODE ? win_dst_row(n0 + n) : (row_off + n0 + n);
            *(GAS v4u*)(WT + (size_t)row * K + k0 + 8 * ch) = o; } }
    LDS_WAIT(); asm volatile("" ::: "memory");
}
__device__ __forceinline__ float wave_sum(float v) {
#pragma unroll
    for (int o = 1; o < 64; o <<= 1) v += __shfl_xor(v, o);
    return v;
}
__device__ __forceinline__ void rms_row_to_bf16(const float* xrow, const float* g, bf16* orow, int lane) {
    const GAS f32x4* xr = (const GAS f32x4*)xrow + lane; const GAS f32x4* gr = (const GAS f32x4*)g + lane;
    f32x4 v[8]; float s = 0.f;
#pragma unroll
    for (int j = 0; j < 8; ++j) { v[j] = xr[64 * j]; s += (v[j].x * v[j].x + v[j].y * v[j].y) + (v[j].z * v[j].z + v[j].w * v[j].w); }
    const float rs = 1.0f / sqrtf(wave_sum(s) * (1.f / 2048.f) + EPS);
    GAS unsigned long long* o8 = (GAS unsigned long long*)orow + lane;
#pragma unroll
    for (int j = 0; j < 8; ++j) { const f32x4 gg = gr[64 * j];
        o8[64 * j] = (unsigned long long)pk2(v[j].x * rs * gg.x, v[j].y * rs * gg.y) | ((unsigned long long)pk2(v[j].z * rs * gg.z, v[j].w * rs * gg.w) << 32); }
}
__device__ __forceinline__ void p0_prologue(const Ptrs& P, LAS unsigned char* lds, int vcu, int G, int wave, int lane, int tid) {
    LAS unsigned char* scr = lds + wave * 16384;
    const int gw = vcu * 8 + wave, NGW = G * 8;
    unsigned char* ws = P.ws;
    bf16* WIN = (bf16*)(ws + WS_WIN); bf16* WP = (bf16*)(ws + WS_WP); bf16* WOUT = (bf16*)(ws + WS_WOUT);
    constexpr int I_IN = 32 * 242, I_MEM = 32 * 32, I_P = 16 * 32, I_O = 32 * 32;
    constexpr int NITEMS = I_IN + I_MEM + 3 * I_P + I_O;
    for (int it = gw; it < NITEMS; it += NGW) {
        int r = it;
        if (r < I_IN) { p0_transpose_item<1>(P.in[10], 2048, D_IN, WIN, 0, scr, r, lane); continue; } r -= I_IN;
        if (r < I_MEM) { p0_transpose_item<0>(P.in[16], 2048, 2048, WIN, NPAD, scr, r, lane); continue; } r -= I_MEM;
        if (r < I_P) { p0_transpose_item<0>(P.in[20], 1024, 2048, WP, 0, scr, r, lane); continue; } r -= I_P;
        if (r < I_P) { p0_transpose_item<0>(P.in[21], 1024, 2048, WP, 2048, scr, r, lane); continue; } r -= I_P;
        if (r < I_P) { p0_transpose_item<0>(P.in[22], 1024, 2048, WP, 4096, scr, r, lane); continue; } r -= I_P;
        p0_transpose_item<0>(P.in[23], 2048, 2048, WOUT, 0, scr, r, lane);
    }
    bf16* XN = (bf16*)(ws + WS_XN);
    for (int m = gw; m < ROWS_A; m += NGW) {
        if (m < TP) rms_row_to_bf16(P.in[0] + (size_t)m * 2048, P.in[9], XN + (size_t)m * 2048, lane);
        else if (m < TP + TS) rms_row_to_bf16(P.in[1] + (size_t)(m - TP) * 2048, P.in[9], XN + (size_t)m * 2048, lane);
        else if (m < ROWS_T) { GAS v4u* o = (GAS v4u*)(XN + (size_t)m * 2048) + lane;
#pragma unroll
            for (int j = 0; j < 4; ++j) o[64 * j] = (v4u){0u, 0u, 0u, 0u}; }
        else rms_row_to_bf16(P.in[8] + (size_t)(m - ROWS_T) * 2048, P.in[15], XN + (size_t)m * 2048, lane);
    }
    const int gt = vcu * 512 + tid, NGT = G * 512;
    { bf16* WST = (bf16*)(ws + WS_WST); const float* w_s = P.in[18];
      for (int i = gt; i < 8 * 128 * 128; i += NGT) { const int p = (i >> 7) & 127, q = i & 127; WST[i] = (bf16)f2bf(q <= p ? w_s[i] : 0.f); } }
    { f32x2* CS = (f32x2*)(ws + WS_CS);
      for (int i = gt; i < 4100 * 96; i += NGT) { const int pp = i / 96, e = i - pp * 96; const int pos = pp < 4096 ? pp : PAST + (pp - 4096);
          const float fr = (e < 64) ? powf(10000.0f, -(float)e / 64.0f) : powf(10000.0f, -(float)(e - 64) / 32.0f);
          const float ang = (float)pos * fr; const double a = (double)ang;
          CS[i] = (f32x2){(float)cos(a), (float)sin(a)}; } }
}

struct SchedIn {
    int G, c;
    __device__ __forceinline__ bool next(int i, pg8::Unit& u) const {
        constexpr int nM = 33, nN = 61, nwg = nM * nN, NX = 8, WGM = 8;
        const int L = i * G + c;
        if (L >= nwg + 16) return false;
        if (L >= nwg) { const int k = L - nwg; u.pm = 33 + (k & 1); u.pn = 61 + (k >> 1); return true; }
        int wgid = L; { const int q = nwg / NX, r = nwg % NX, xcd = wgid % NX, off = wgid / NX; wgid = (xcd < r ? xcd * (q + 1) : r * (q + 1) + (xcd - r) * q) + off; }
        const int nig = WGM * nN, gid = wgid / nig, fm = gid * WGM, gsz = (nM - fm) < WGM ? (nM - fm) : WGM;
        u.pm = fm + ((wgid % nig) % gsz); u.pn = (wgid % nig) / gsz; return true;
    }
    __device__ __forceinline__ void a_ready(const pg8::Unit&) const {}
    __device__ __forceinline__ void done(const pg8::Unit&) const {}
};

struct EpiIn {
    static constexpr bool PERM = true, AFTER_DRAIN = false, KEEP_ACC = false;
    float* out; unsigned char* ws; const float *g_q, *g_k, *g_mq, *g_mk; LAS float* xch;
    __device__ __forceinline__ void operator()(const pg8::f32x4 (&acc)[2][2][4][2], const pg8::Unit& u, int wr, int wc, int fr, int fq) const {
        asm volatile("" : "+v"(fr), "+v"(fq));
        asm volatile("" : "+s"(wr), "+s"(wc));
        const int pn = u.pn, pm = u.pm;
        const int rl0 = 64 * wr + fr;
        const int R0 = 256 * pm + rl0;
        const bool samp = (pm == 32);
        const int cl0 = 32 * wc + 8 * fq;
        const f32x2* CS = (const f32x2*)(ws + WS_CS);
#define ROWLOOP _Pragma("unroll") for (int ai = 0; ai < 2; ++ai) _Pragma("unroll") for (int m = 0; m < 4; ++m)
        if (pm >= 33) {
            const int Rm0 = 256 * (pm - 33) + rl0;
            if (pn <= 64) {
                const int head = pn - 61;
                ROWLOOP { float ss = 0.f;
#pragma unroll
                    for (int bj = 0; bj < 2; ++bj)
#pragma unroll
                        for (int n = 0; n < 2; ++n) { const pg8::f32x4 x = acc[ai][bj][m][n]; ss += (x[0] * x[0] + x[1] * x[1]) + (x[2] * x[2] + x[3] * x[3]); }
                    ss += __shfl_xor(ss, 16); ss += __shfl_xor(ss, 32);
                    if (fq == 0) xch[(128 * ai + 16 * m + rl0) * 8 + wc] = ss; }
                BAR_LDS();
                pg8::f32x4 gg[2][2];
#pragma unroll
                for (int bj = 0; bj < 2; ++bj)
#pragma unroll
                    for (int n = 0; n < 2; ++n) gg[bj][n] = *(const pg8::f32x4*)(g_mk + 128 * bj + cl0 + 4 * n);
                bf16* MK = (bf16*)(ws + WS_MK);
                ROWLOOP { const int rl = 128 * ai + 16 * m + rl0; const LAS float* xr = xch + rl * 8;
                    const float rs = 1.0f / sqrtf(((xr[0] + xr[1]) + (xr[2] + xr[3])) * (1.f / 256.f) + EPS);
                    const size_t ro = (size_t)(Rm0 + 128 * ai + 16 * m) * 1024 + head * 256;
#pragma unroll
                    for (int bj = 0; bj < 2; ++bj) { const pg8::f32x4 v0 = acc[ai][bj][m][0] * rs * gg[bj][0], v1 = acc[ai][bj][m][1] * rs * gg[bj][1];
                        float* o = out + O_MKP + ro + 128 * bj + cl0; *(pg8::f32x4*)o = v0; *(pg8::f32x4*)(o + 4) = v1;
                        *(v4u*)(MK + ro + 128 * bj + cl0) = (v4u){cvtpk(v0[0], v0[1]), cvtpk(v0[2], v0[3]), cvtpk(v1[0], v1[1]), cvtpk(v1[2], v1[3])}; } }
            } else {
                bf16* MV = (bf16*)(ws + WS_MV);
                ROWLOOP { const size_t ro = (size_t)(Rm0 + 128 * ai + 16 * m) * 1024 + (pn - 65) * 256;
#pragma unroll
                    for (int bj = 0; bj < 2; ++bj) { const pg8::f32x4 v0 = acc[ai][bj][m][0], v1 = acc[ai][bj][m][1];
                        float* o = out + O_MVP + ro + 128 * bj + cl0; *(pg8::f32x4*)o = v0; *(pg8::f32x4*)(o + 4) = v1;
                        *(v4u*)(MV + ro + 128 * bj + cl0) = (v4u){cvtpk(v0[0], v0[1]), cvtpk(v0[2], v0[3]), cvtpk(v1[0], v1[1]), cvtpk(v1[2], v1[3])}; } }
            }
            return;
        }
        if (pn < 6) {
            const bool isq = pn < 4; const float* G = isq ? g_q : g_k;
            ROWLOOP {
#pragma unroll
                for (int bj = 0; bj < 2; ++bj) { const pg8::f32x4 x = acc[ai][bj][m][0], y = acc[ai][bj][m][1];
                    float ss = ((x[0] * x[0] + x[1] * x[1]) + (x[2] * x[2] + x[3] * x[3])) + ((y[0] * y[0] + y[1] * y[1]) + (y[2] * y[2] + y[3] * y[3]));
                    ss += __shfl_xor(ss, 16); ss += __shfl_xor(ss, 32);
                    if (fq == 0) xch[(128 * ai + 16 * m + rl0) * 8 + wc * 2 + bj] = ss; } }
            BAR_LDS();
            const int d0 = 16 * wc + 4 * fq;
            const pg8::f32x4 g1 = *(const pg8::f32x4*)(G + d0), g2 = *(const pg8::f32x4*)(G + 64 + d0);
            bf16* QB = (bf16*)(ws + WS_QB); bf16* KB = (bf16*)(ws + WS_KB);
            ROWLOOP { const int rl = 128 * ai + 16 * m + rl0; const int R = R0 + 128 * ai + 16 * m;
                const int pidx = samp ? 4096 + ((R - TP) & 3) : (R & 4095);
                const pg8::f32x4 cs0 = *(const pg8::f32x4*)(CS + (size_t)pidx * 96 + d0), cs1 = *(const pg8::f32x4*)(CS + (size_t)pidx * 96 + d0 + 2);
                const float cc[4] = {cs0[0], cs0[2], cs1[0], cs1[2]}, sn[4] = {cs0[1], cs0[3], cs1[1], cs1[3]};
                const LAS float* xr = xch + rl * 8;
#pragma unroll
                for (int bj = 0; bj < 2; ++bj) {
                    const float rs = 1.0f / sqrtf(((xr[bj] + xr[2 + bj]) + (xr[4 + bj] + xr[6 + bj])) * (1.f / 128.f) + EPS);
                    const pg8::f32x4 y1 = acc[ai][bj][m][0] * rs * g1, y2 = acc[ai][bj][m][1] * rs * g2;
                    pg8::f32x4 o1, o2;
#pragma unroll
                    for (int e = 0; e < 4; ++e) { o1[e] = y1[e] * cc[e] - y2[e] * sn[e]; o2[e] = y2[e] * cc[e] + y1[e] * sn[e]; }
                    if (isq) { const size_t off = (size_t)R * 1024 + (2 * pn + bj) * 128 + d0;
                        *(u32x2*)(QB + off) = (u32x2){cvtpk(o1[0] * QS_A, o1[1] * QS_A), cvtpk(o1[2] * QS_A, o1[3] * QS_A)};
                        *(u32x2*)(QB + off + 64) = (u32x2){cvtpk(o2[0] * QS_A, o2[1] * QS_A), cvtpk(o2[2] * QS_A, o2[3] * QS_A)};
                    } else { const int hd = 2 * (pn - 4) + bj; const size_t off = (size_t)R * 512 + hd * 128 + d0;
                        *(u32x2*)(KB + off) = (u32x2){cvtpk(o1[0], o1[1]), cvtpk(o1[2], o1[3])};
                        *(u32x2*)(KB + off + 64) = (u32x2){cvtpk(o2[0], o2[1]), cvtpk(o2[2], o2[3])};
                        if (!samp) { float* o = out + O_KP + off; *(pg8::f32x4*)o = o1; *(pg8::f32x4*)(o + 64) = o2; }
                        else if (R - TP < TS) { float* o = out + O_KS + (size_t)(R - TP) * 512 + hd * 128 + d0; *(pg8::f32x4*)o = o1; *(pg8::f32x4*)(o + 64) = o2; } } } }
            return;
        }
        if (pn < 8) {
            bf16* VB = (bf16*)(ws + WS_VB);
            ROWLOOP { const int R = R0 + 128 * ai + 16 * m;
#pragma unroll
                for (int bj = 0; bj < 2; ++bj) { const pg8::f32x4 v0 = acc[ai][bj][m][0], v1 = acc[ai][bj][m][1]; const int col = 256 * (pn - 6) + 128 * bj + cl0;
                    *(v4u*)(VB + (size_t)R * 512 + col) = (v4u){cvtpk(v0[0], v0[1]), cvtpk(v0[2], v0[3]), cvtpk(v1[0], v1[1]), cvtpk(v1[2], v1[3])};
                    if (!samp) { float* o = out + O_VP + (size_t)R * 512 + col; *(pg8::f32x4*)o = v0; *(pg8::f32x4*)(o + 4) = v1; }
                    else if (R - TP < TS) { float* o = out + O_VS + (size_t)(R - TP) * 512 + col; *(pg8::f32x4*)o = v0; *(pg8::f32x4*)(o + 4) = v1; } } }
            return;
        }
        if (pn < 12) {
            _Float16* QI = (_Float16*)(ws + WS_QI);
            const int dlo = 16 * (wc & 1) + 4 * fq;
            ROWLOOP { const int R = R0 + 128 * ai + 16 * m; const int pidx = samp ? 4096 + ((R - TP) & 3) : (R & 4095);
                const pg8::f32x4 cs0 = *(const pg8::f32x4*)(CS + (size_t)pidx * 96 + 64 + dlo), cs1 = *(const pg8::f32x4*)(CS + (size_t)pidx * 96 + 64 + dlo + 2);
                const float cc[4] = {cs0[0], cs0[2], cs1[0], cs1[2]}, sn[4] = {cs0[1], cs0[3], cs1[1], cs1[3]};
#pragma unroll
                for (int bj = 0; bj < 2; ++bj) { const pg8::f32x4 x1 = acc[ai][bj][m][0], x2 = acc[ai][bj][m][1]; pg8::f32x4 o1, o2;
#pragma unroll
                    for (int e = 0; e < 4; ++e) { o1[e] = (x1[e] * cc[e] - x2[e] * sn[e]) * 0.125f; o2[e] = (x2[e] * cc[e] + x1[e] * sn[e]) * 0.125f; }
                    const int head = 4 * (pn - 8) + 2 * bj + (wc >> 1); const size_t off = (size_t)R * 1024 + head * 64 + dlo;
                    *(u32x2*)(QI + off) = (u32x2){cvtpk_h(o1[0], o1[1]), cvtpk_h(o1[2], o1[3])};
                    *(u32x2*)(QI + off + 32) = (u32x2){cvtpk_h(o2[0], o2[1]), cvtpk_h(o2[2], o2[3])}; } }
            return;
        }
        if (pn == 60) {
            _Float16* KI = (_Float16*)(ws + WS_KI); float* WI = (float*)(ws + WS_WI);
            const int dlo = 16 * (wc & 1) + 4 * fq;
            ROWLOOP { const int R = R0 + 128 * ai + 16 * m; const int pidx = samp ? 4096 + ((R - TP) & 3) : (R & 4095);
                const pg8::f32x4 x1 = acc[ai][0][m][0], x2 = acc[ai][0][m][1];
                if (wc < 2) {
                    const pg8::f32x4 cs0 = *(const pg8::f32x4*)(CS + (size_t)pidx * 96 + 64 + dlo), cs1 = *(const pg8::f32x4*)(CS + (size_t)pidx * 96 + 64 + dlo + 2);
                    const float cc[4] = {cs0[0], cs0[2], cs1[0], cs1[2]}, sn[4] = {cs0[1], cs0[3], cs1[1], cs1[3]};
                    pg8::f32x4 o1, o2;
#pragma unroll
                    for (int e = 0; e < 4; ++e) { o1[e] = x1[e] * cc[e] - x2[e] * sn[e]; o2[e] = x2[e] * cc[e] + x1[e] * sn[e]; }
                    const size_t off = (size_t)R * 64 + dlo;
                    *(u32x2*)(KI + off) = (u32x2){cvtpk_h(o1[0], o1[1]), cvtpk_h(o1[2], o1[3])};
                    *(u32x2*)(KI + off + 32) = (u32x2){cvtpk_h(o2[0], o2[1]), cvtpk_h(o2[2], o2[3])};
                    if (!samp) { float* o = out + O_KIP + off; *(pg8::f32x4*)o = o1; *(pg8::f32x4*)(o + 32) = o2; }
                    else if (R - TP < TS) { float* o = out + O_KIS + (size_t)(R - TP) * 64 + dlo; *(pg8::f32x4*)o = o1; *(pg8::f32x4*)(o + 32) = o2; }
                } else if (wc == 2 && fq < 2) {
                    float* o = WI + (size_t)R * 16 + 8 * fq; *(pg8::f32x4*)o = x1 * 0.25f; *(pg8::f32x4*)(o + 4) = x2 * 0.25f;
                } }
            return;
        }
        if (pn >= 20 && pn < 24) {
            float* BV = (float*)(ws + WS_BV); float* SSQ = (float*)(ws + WS_SSQ);
            ROWLOOP { const int R = R0 + 128 * ai + 16 * m; float ss = 0.f;
#pragma unroll
                for (int bj = 0; bj < 2; ++bj) { const pg8::f32x4 v0 = acc[ai][bj][m][0], v1 = acc[ai][bj][m][1];
                    ss += ((v0[0] * v0[0] + v0[1] * v0[1]) + (v0[2] * v0[2] + v0[3] * v0[3])) + ((v1[0] * v1[0] + v1[1] * v1[1]) + (v1[2] * v1[2] + v1[3] * v1[3]));
                    float* o = BV + (size_t)R * 1024 + 256 * (pn - 20) + 128 * bj + cl0; *(pg8::f32x4*)o = v0; *(pg8::f32x4*)(o + 4) = v1; }
                ss += __shfl_xor(ss, 16); ss += __shfl_xor(ss, 32);
                if (fq == 0) SSQ[(size_t)R * 16 + (pn - 20) * 4 + wc] = ss; }
            return;
        }
        if (pn >= 28 && pn < 32) {
            const int head = pn - 28;
            ROWLOOP { float ss = 0.f;
#pragma unroll
                for (int bj = 0; bj < 2; ++bj)
#pragma unroll
                    for (int n = 0; n < 2; ++n) { const pg8::f32x4 x = acc[ai][bj][m][n]; ss += (x[0] * x[0] + x[1] * x[1]) + (x[2] * x[2] + x[3] * x[3]); }
                ss += __shfl_xor(ss, 16); ss += __shfl_xor(ss, 32);
                if (fq == 0) xch[(128 * ai + 16 * m + rl0) * 8 + wc] = ss; }
            BAR_LDS();
            pg8::f32x4 gg[2][2];
#pragma unroll
            for (int bj = 0; bj < 2; ++bj)
#pragma unroll
                for (int n = 0; n < 2; ++n) gg[bj][n] = *(const pg8::f32x4*)(g_mq + 128 * bj + cl0 + 4 * n) * QS_C;
            bf16* QC = (bf16*)(ws + WS_QC);
            ROWLOOP { const int rl = 128 * ai + 16 * m + rl0; const LAS float* xr = xch + rl * 8;
                const float rs = 1.0f / sqrtf(((xr[0] + xr[1]) + (xr[2] + xr[3])) * (1.f / 256.f) + EPS);
                const size_t ro = (size_t)(R0 + 128 * ai + 16 * m) * 1024 + head * 256;
#pragma unroll
                for (int bj = 0; bj < 2; ++bj) { const pg8::f32x4 v0 = acc[ai][bj][m][0] * rs * gg[bj][0], v1 = acc[ai][bj][m][1] * rs * gg[bj][1];
                    *(v4u*)(QC + ro + 128 * bj + cl0) = (v4u){cvtpk(v0[0], v0[1]), cvtpk(v0[2], v0[3]), cvtpk(v1[0], v1[1]), cvtpk(v1[2], v1[3])}; } }
            return;
        }
        int mode; bf16* dst; int ld, colt;
        if (pn < 16) { mode = 1; dst = (bf16*)(ws + WS_SGA); ld = 1024; colt = 256 * (pn - 12); }
        else if (pn < 20) { mode = 0; dst = (bf16*)(ws + WS_BU); ld = 1024; colt = 256 * (pn - 16); }
        else if (pn < 28) { mode = 1; dst = (bf16*)(ws + WS_SGB); ld = 1024; colt = 256 * (pn - 24); }
        else if (pn < 36) { mode = 1; dst = (bf16*)(ws + WS_SGC); ld = 1024; colt = 256 * (pn - 32); }
        else { mode = 2; const int k = pn - 36; dst = (bf16*)(ws + WS_R) + (size_t)(k >> 3) * R_STRIDE; ld = 2048; colt = 256 * (k & 7); }
        ROWLOOP { const int R = R0 + 128 * ai + 16 * m;
#pragma unroll
            for (int bj = 0; bj < 2; ++bj) { pg8::f32x4 v0 = acc[ai][bj][m][0], v1 = acc[ai][bj][m][1];
                if (mode == 1) {
#pragma unroll
                    for (int e = 0; e < 4; ++e) { v0[e] = siluf_(v0[e]); v1[e] = siluf_(v1[e]); } }
                else if (mode == 2) {
#pragma unroll
                    for (int e = 0; e < 4; ++e) { v0[e] = sigmoidf_(v0[e]); v1[e] = sigmoidf_(v1[e]); } }
                *(v4u*)(dst + (size_t)R * ld + colt + 128 * bj + cl0) = (v4u){cvtpk(v0[0], v0[1]), cvtpk(v0[2], v0[3]), cvtpk(v1[0], v1[1]), cvtpk(v1[2], v1[3])}; } }
#undef ROWLOOP
    }
};

typedef short v4i16_t __attribute__((ext_vector_type(4)));
#define KSWZ(row, colB) ((row) * 256 + ((colB) ^ (((row) & 7) << 4)))
__device__ __forceinline__ int v_st(int k, int c) { const int kk = (k & ~0xC) | ((k & 4) << 1) | ((k & 8) >> 1); return ((kk >> 3) * 4 + (c >> 5)) * 512 + ((kk & 7) * 32 + (c & 31)) * 2; }
__device__ __forceinline__ int v_rd_base(int lane) { return ((lane & 3) << 3) | (((lane >> 2) & 3) << 6) | (((lane >> 4) & 1) << 5) | (((lane >> 5) & 1) << 8); }
__device__ __forceinline__ s16x4 vtr(const LAS unsigned char* p) { return __builtin_bit_cast(s16x4, __builtin_amdgcn_ds_read_tr16_b64_v4i16((LAS v4i16_t*)p)); }
#define VFRAG(l_, h_) (bf16x8){(l_)[0], (l_)[1], (l_)[2], (l_)[3], (h_)[0], (h_)[1], (h_)[2], (h_)[3]}
#define PK4(P, B_, OUT) do { const unsigned a0 = cvtpk(P[B_ + 0], P[B_ + 1]), a1 = cvtpk(P[B_ + 2], P[B_ + 3]);                       \
        const unsigned b0 = cvtpk(P[B_ + 4], P[B_ + 5]), b1 = cvtpk(P[B_ + 6], P[B_ + 7]);                                          \
        auto r0 = __builtin_amdgcn_permlane32_swap(a0, b0, false, false); auto r1 = __builtin_amdgcn_permlane32_swap(a1, b1, false, false); \
        v4u w_ = {r0[0], r1[0], r0[1], r1[1]}; OUT = __builtin_bit_cast(bf16x8, w_); } while (0)
__device__ __forceinline__ float relu_s(float a) { const int b = __builtin_bit_cast(int, a); return __builtin_bit_cast(float, b > 0 ? b : 0); }
__device__ __forceinline__ float wave_max(float v) {
#pragma unroll
    for (int o = 1; o < 64; o <<= 1) v = fmaxf(v, __shfl_xor(v, o));
    return v;
}
__device__ __forceinline__ float logit_bound(const float* gq, const float* gk, int D, int lane) {
    float a = 0.f, c = 0.f;
    for (int i = lane; i < D; i += 64) { a = fmaxf(a, fabsf(gq[i])); c = fmaxf(c, fabsf(gk[i])); }
    return sqrtf((float)D) * wave_max(a) * wave_max(c) * LOG2E;
}

__device__ __forceinline__ void idx_stage_offsets(unsigned (&voff)[4], int wid, int lane) {
#pragma unroll
    for (int i = 0; i < 4; ++i) { const int pc = wid * 4 + i; const int r = 8 * pc + (lane >> 3); const int ch = (lane & 7) ^ ((r >> 1) & 7);
        voff[i] = (unsigned)(r * 128 + ch * 16); asm volatile("" : "+v"(voff[i])); }
}
__device__ __forceinline__ void idx_stage_chunk(LAS unsigned char* buf, const char* cbase  , const unsigned (&voff)[4], int wid) {
#pragma unroll
    for (int i = 0; i < 4; ++i)
        __builtin_amdgcn_global_load_lds((const unsigned*)(cbase + voff[i]), (LAS unsigned*)(buf + (wid * 4 + i) * 1024), 16, 0, 0);
}
#define IDX_COUNT(PRED, CNT) { unsigned cl_ = 0; _Pragma("unroll") for (int j = 0; j < NT; ++j) { cl_ += (PRED) ? 1u : 0u; if ((j & 15) == 15) __builtin_amdgcn_sched_barrier(0); } \
        _Pragma("unroll") for (int o_ = 1; o_ < 32; o_ <<= 1) cl_ += __shfl_xor(cl_, o_); CNT = cl_; }
template <int NCH>
__device__ __forceinline__ void indexer_unit(LAS unsigned char* lds, const unsigned char* ws, int b, int p, int wid, int lane) {
    constexpr int NT = 8 * NCH;
    const _Float16* QI = (const _Float16*)(ws + WS_QI); const _Float16* KIb = (const _Float16*)(ws + WS_KI) + (size_t)b * 4096 * 64;
    const float* WI = (const float*)(ws + WS_WI); unsigned* MASK = (unsigned*)(ws + WS_MASK);
    const int r32 = lane & 31, hi = lane >> 5;
    const int t0 = 16 * p + 2 * wid;
    const float NEG = -__builtin_inff();
    h8 qa[4];
    { const int tok = t0 + ((lane >> 2) & 1), head = (lane & 3) + 4 * (r32 >> 3);
      const _Float16* qp = QI + ((size_t)(b * 4096 + tok) * 1024 + head * 64 + 8 * hi);
#pragma unroll
      for (int s = 0; s < 4; ++s) qa[s] = *(const h8*)(qp + 16 * s); }
    float w[16];
    { const float* wp = WI + (size_t)(b * 4096 + t0 + hi) * 16;
#pragma unroll
      for (int k = 0; k < 4; ++k) { const f32x4 t = *(const f32x4*)(wp + 4 * k); w[4 * k] = t[0]; w[4 * k + 1] = t[1]; w[4 * k + 2] = t[2]; w[4 * k + 3] = t[3]; } }
    float sc[NT];
    unsigned voff[4]; idx_stage_offsets(voff, wid, lane);
    const char* kib = (const char*)KIb;
    idx_stage_chunk(lds, kib, voff, wid);
    asm volatile("s_waitcnt vmcnt(0)" ::: "memory"); __syncthreads();
    const int tcur = t0 + hi - r32;
    const LAS unsigned char* kb_base[4];
#pragma unroll
    for (int s = 0; s < 4; ++s) { kb_base[s] = lds + r32 * 128 + (((2 * s + hi) ^ ((r32 >> 1) & 7)) << 4); asm volatile("" : "+v"(kb_base[s])); }
#pragma unroll
    for (int c = 0; c < NCH; ++c) {
        if (c + 1 < NCH) idx_stage_chunk(lds + ((c + 1) & 1) * 32768, kib + (size_t)(c + 1) * 32768, voff, wid);
#ifdef DBG_SERIAL_DMA
        asm volatile("s_waitcnt vmcnt(0)" ::: "memory"); __syncthreads();
#endif
#pragma unroll
        for (int i = 0; i < 8; ++i) { const int j = 8 * c + i;
            f32x16 acc = {};
#pragma unroll
            for (int s = 0; s < 4; ++s) {
                const h8 kb = *(const LAS h8*)(kb_base[s] + ((c & 1) * 32768 + i * 4096));
                acc = __builtin_amdgcn_mfma_f32_32x32x16_f16(qa[s], kb, acc, 0, 0, 0); }
            float s_ = 0.f;
#pragma unroll
            for (int r = 0; r < 16; ++r) s_ = fmaf(relu_s(acc[r]), w[r], s_);
            s_ = (32 * j <= tcur) ? s_ : NEG;
            asm volatile("" : "+v"(s_));
            sc[j] = s_;
            __builtin_amdgcn_sched_barrier(0);
        }
        asm volatile("s_waitcnt vmcnt(0)" ::: "memory"); __syncthreads();
    }
    float thr = NEG, tv = 0.f; bool tie = false; int X = 0;
    if (t0 + 2 > TOPK) {
        float mn = __builtin_inff(), mx = NEG;
#pragma unroll
        for (int j = 0; j < NT; ++j) { const float v = sc[j]; mx = fmaxf(mx, v); mn = fminf(mn, v == NEG ? __builtin_inff() : v); }
#pragma unroll
        for (int o = 1; o < 32; o <<= 1) { mn = fminf(mn, __shfl_xor(mn, o)); mx = fmaxf(mx, __shfl_xor(mx, o)); }
        float lo = mn - (mx - mn) - 1.0f - fabsf(mn) * 1e-6f, hv = mx; bool done = false;
        for (int it = 0; it < 256; ++it) {
            const float mid = 0.5f * (lo + hv);
            const bool adj = !(mid > lo && mid < hv);
            unsigned c;
            IDX_COUNT(sc[j] > mid, c)
            if (!done) { if (adj) { done = true; tie = true; tv = hv; thr = hv; }
                         else if (c == (unsigned)TOPK) { thr = mid; done = true; }
                         else if (c > (unsigned)TOPK) lo = mid; else hv = mid; }
            if (__all(done)) break;
        }
        if (__any(tie)) {
            unsigned cgt;
            IDX_COUNT(sc[j] > tv, cgt)
            const int need = TOPK - (int)cgt;
            int loX = 0, hiX = 4096;
            for (int it = 0; it < 12; ++it) { const int midX = (loX + hiX) >> 1; unsigned eq; asm volatile("" : "+v"(tv));
                IDX_COUNT(sc[j] == tv && (32 * j + r32) < midX, eq)
                if ((int)eq >= need) hiX = midX; else loX = midX; }
            X = hiX;
        }
    }
    unsigned W00 = 0, W01 = 0, W10 = 0, W11 = 0;
#pragma unroll
    for (int j = 0; j < NT; ++j) {
        const bool sel = (sc[j] > thr) || (tie && sc[j] == tv && (32 * j + r32) < X);
        const unsigned long long bm = __ballot(sel);
        const unsigned blo = (unsigned)bm, bhi = (unsigned)(bm >> 32);
        if (j < 64) { asm volatile("s_nop 1\n\tv_writelane_b32 %0, %1, %2" : "+v"(W00) : "s"(blo), "n"(j & 63)); asm volatile("s_nop 1\n\tv_writelane_b32 %0, %1, %2" : "+v"(W10) : "s"(bhi), "n"(j & 63)); }
        else { asm volatile("s_nop 1\n\tv_writelane_b32 %0, %1, %2" : "+v"(W01) : "s"(blo), "n"(j & 63)); asm volatile("s_nop 1\n\tv_writelane_b32 %0, %1, %2" : "+v"(W11) : "s"(bhi), "n"(j & 63)); }
        if ((j & 15) == 15) __builtin_amdgcn_sched_barrier(0); }
    unsigned* mr = MASK + (size_t)(b * 4096 + t0) * 128;
    mr[lane] = W00; mr[64 + lane] = W01; mr[128 + lane] = W10; mr[192 + lane] = W11;
}
__device__ __forceinline__ void indexer_dispatch(LAS unsigned char* lds, const unsigned char* ws, int b, int p, int wid, int lane) {
#ifdef IDX_FORCE
    indexer_unit<IDX_FORCE>(lds, ws, b, p, wid, lane); return;
#endif
    if (p < 64) indexer_unit<4>(lds, ws, b, p, wid, lane);
    else if (p < 128) indexer_unit<8>(lds, ws, b, p, wid, lane);
    else if (p < 192) indexer_unit<12>(lds, ws, b, p, wid, lane);
    else indexer_unit<16>(lds, ws, b, p, wid, lane);
}

__device__ __forceinline__ void chunkmix_unit(LAS unsigned char* lds, const Ptrs& P, int cg, int g, int tid, int wid, int lane) {
    const unsigned char* ws = P.ws;
    const float* BV = (const float*)(ws + WS_BV); const float* SSQ = (const float*)(ws + WS_SSQ);
    const bf16* BU = (const bf16*)(ws + WS_BU); const bf16* SGB = (const bf16*)(ws + WS_SGB); const bf16* WST = (const bf16*)(ws + WS_WST);
    bf16* ZB = (bf16*)(ws + WS_Z) + Z_STRIDE;
    const float* gsgu = P.in[17]; const float* b_s = P.in[19];
    const int Rbase = cg * 128;
    { const int sr = tid >> 4, scol = (tid & 15) * 8;
      const f32x4 g0 = *(const f32x4*)(gsgu + g * 128 + scol), g1 = *(const f32x4*)(gsgu + g * 128 + scol + 4);
#pragma unroll
      for (int k = 0; k < 4; ++k) { const int q = sr + 32 * k; const size_t R = (size_t)(Rbase + q);
          const f32x4 s0 = *(const f32x4*)(SSQ + R * 16), s1 = *(const f32x4*)(SSQ + R * 16 + 4), s2 = *(const f32x4*)(SSQ + R * 16 + 8), s3 = *(const f32x4*)(SSQ + R * 16 + 12);
          const float ss = (((s0[0] + s0[1]) + (s0[2] + s0[3])) + ((s1[0] + s1[1]) + (s1[2] + s1[3]))) + (((s2[0] + s2[1]) + (s2[2] + s2[3])) + ((s3[0] + s3[1]) + (s3[2] + s3[3])));
          const float rs = 1.0f / sqrtf(ss * (1.f / 1024.f) + EPS);
          const f32x4 x0 = *(const f32x4*)(BV + R * 1024 + g * 128 + scol) * rs * g0, x1 = *(const f32x4*)(BV + R * 1024 + g * 128 + scol + 4) * rs * g1;
          *(LAS v4u*)(lds + (q >> 6) * 16384 + v_st(q & 63, scol)) = (v4u){cvtpk(x0[0], x0[1]), cvtpk(x0[2], x0[3]), cvtpk(x1[0], x1[1]), cvtpk(x1[2], x1[3])}; } }
    __syncthreads();
    const int pb = wid & 3, chh = wid >> 2, r32 = lane & 31, hi = lane >> 5;
    f32x16 o[2]; o[0] = f32x16{}; o[1] = f32x16{};
    const bf16* wsp = WST + ((size_t)(g * 128 + 32 * pb + r32) * 128 + 8 * hi);
    const LAS unsigned char* vp = lds + v_rd_base(lane);
#pragma unroll
    for (int ks = 0; ks < 8; ++ks) {
        if (ks < 2 * pb + 2) {
            const bf16x8 pa = *(const bf16x8*)(wsp + 16 * ks);
#pragma unroll
            for (int d0l = 0; d0l < 2; ++d0l) { const int d0 = 2 * chh + d0l;
                const s16x4 lo = vtr(vp + (ks >> 2) * 16384 + d0 * 512 + (ks & 3) * 4096), hh = vtr(vp + (ks >> 2) * 16384 + d0 * 512 + (ks & 3) * 4096 + 2048);
                o[d0l] = __builtin_amdgcn_mfma_f32_32x32x16_bf16(pa, VFRAG(lo, hh), o[d0l], 0, 0, 0); }
        }
    }
#pragma unroll
    for (int d0l = 0; d0l < 2; ++d0l)
#pragma unroll
        for (int r = 0; r < 16; ++r) { const int pp = 32 * pb + crow(r, hi), c = 32 * (2 * chh + d0l) + r32; const size_t off = (size_t)(Rbase + pp) * 1024 + g * 128 + c;
            const float s = o[d0l][r] + b_s[g * 128 + pp];
            const float val = bf2f(BU[off]) * s * bf2f(SGB[off]);
            const float vn_ = __shfl_xor(val, 1);
            if ((r32 & 1) == 0) *(unsigned*)(ZB + off) = cvtpk(val, vn_); }
    __syncthreads();
}

__device__ __forceinline__ void memattn_unit(LAS unsigned char* lds, LAS float* xch, const Ptrs& P, int b, int h, int qb, float M2, int tid, int wid, int lane) {
    const unsigned char* ws = P.ws;
    const bf16* QC = (const bf16*)(ws + WS_QC); const bf16* MK = (const bf16*)(ws + WS_MK); const bf16* MV = (const bf16*)(ws + WS_MV); const bf16* SGC = (const bf16*)(ws + WS_SGC);
    bf16* ZC = (bf16*)(ws + WS_Z) + 2 * Z_STRIDE;
    const int rg = wid & 3, par = wid >> 2, r32 = lane & 31, hi = lane >> 5;
    const size_t Rq = (size_t)b * 4096 + 128 * qb + 32 * rg + r32;
#pragma unroll
    for (int half = 0; half < 2; ++half) { v4u st[8];
#pragma unroll
        for (int i = 0; i < 8; ++i) { const int cidx = tid + 512 * (8 * half + i); const int key = cidx >> 5, c16 = cidx & 31;
            st[i] = *(const v4u*)(MK + (size_t)(b * 256 + key) * 1024 + h * 256 + c16 * 8); }
#pragma unroll
        for (int i = 0; i < 8; ++i) { const int cidx = tid + 512 * (8 * half + i); const int key = cidx >> 5, c16 = cidx & 31;
            *(LAS v4u*)(lds + (key >> 6) * 32768 + (c16 >> 4) * 16384 + KSWZ(key & 63, (c16 & 15) * 16)) = st[i]; } }
    __syncthreads();
    f32x16 p[2][2];
#pragma unroll
    for (int tt = 0; tt < 2; ++tt)
#pragma unroll
        for (int k = 0; k < 2; ++k)
#pragma unroll
            for (int r = 0; r < 16; ++r) p[tt][k][r] = -M2;
    { const bf16* qp = QC + Rq * 1024 + h * 256 + 8 * hi;
#pragma unroll
      for (int s = 0; s < 16; ++s) { const bf16x8 qf = *(const bf16x8*)(qp + 16 * s);
#pragma unroll
          for (int tt = 0; tt < 2; ++tt) { const LAS unsigned char* a = lds + (2 * par + tt) * 32768 + (s >> 3) * 16384 + KSWZ(r32, ((s & 7) * 16 + hi * 8) * 2);
              const bf16x8 b0 = *(const LAS bf16x8*)a, b1 = *(const LAS bf16x8*)(a + 32 * 256);
              p[tt][0] = __builtin_amdgcn_mfma_f32_32x32x16_bf16(b0, qf, p[tt][0], 0, 0, 0);
              p[tt][1] = __builtin_amdgcn_mfma_f32_32x32x16_bf16(b1, qf, p[tt][1], 0, 0, 0); } } }
    float l = 0.f; bf16x8 pa[2][4];
#pragma unroll
    for (int tt = 0; tt < 2; ++tt) {
#pragma unroll
        for (int k = 0; k < 2; ++k)
#pragma unroll
            for (int r = 0; r < 16; ++r) { const float e = __builtin_amdgcn_exp2f(p[tt][k][r]); p[tt][k][r] = e; l += e; }
        PK4(p[tt][0], 0, pa[tt][0]); PK4(p[tt][0], 8, pa[tt][1]); PK4(p[tt][1], 0, pa[tt][2]); PK4(p[tt][1], 8, pa[tt][3]);
    }
    __syncthreads();
#pragma unroll
    for (int half = 0; half < 2; ++half) { v4u st[8];
#pragma unroll
        for (int i = 0; i < 8; ++i) { const int cidx = tid + 512 * (8 * half + i); const int key = cidx >> 5, c16 = cidx & 31;
            st[i] = *(const v4u*)(MV + (size_t)(b * 256 + key) * 1024 + h * 256 + c16 * 8); }
#pragma unroll
        for (int i = 0; i < 8; ++i) { const int cidx = tid + 512 * (8 * half + i); const int key = cidx >> 5, c16 = cidx & 31;
            *(LAS v4u*)(lds + (key >> 6) * 32768 + (c16 >> 4) * 16384 + v_st(key & 63, (c16 & 15) * 8)) = st[i]; } }
    __syncthreads();
    f32x16 o[8];
#pragma unroll
    for (int d0 = 0; d0 < 8; ++d0) o[d0] = f32x16{};
#pragma unroll
    for (int tt = 0; tt < 2; ++tt)
#pragma unroll
        for (int d0 = 0; d0 < 8; ++d0) { const LAS unsigned char* vp = lds + (2 * par + tt) * 32768 + (d0 >> 2) * 16384 + v_rd_base(lane) + (d0 & 3) * 512;
#pragma unroll
            for (int ks = 0; ks < 4; ++ks) { const s16x4 lo = vtr(vp + ks * 4096), hh = vtr(vp + ks * 4096 + 2048);
                o[d0] = __builtin_amdgcn_mfma_f32_32x32x16_bf16(pa[tt][ks], VFRAG(lo, hh), o[d0], 0, 0, 0); } }
    __syncthreads();
    l += __shfl_xor(l, 32);
    LAS float* OM = (LAS float*)lds + rg * 8192; LAS float* LM = xch + rg * 32; LAS float* LM2 = xch + 128 + wid * 32;
    if (par == 1) {
#pragma unroll
        for (int d0 = 0; d0 < 8; ++d0)
#pragma unroll
            for (int r = 0; r < 16; ++r) OM[(d0 * 16 + r) * 64 + lane] = o[d0][r];
        if (hi == 0) LM[r32] = l;
    }
    __syncthreads();
    if (par == 0) {
        l += LM[r32];
        if (hi == 0) LM2[r32] = l;
        float rl[16];
#pragma unroll
        for (int r = 0; r < 16; ++r) rl[r] = 1.0f / LM2[crow(r, hi)];
#pragma unroll
        for (int d0 = 0; d0 < 8; ++d0)
#pragma unroll
            for (int r = 0; r < 16; ++r) { const size_t off = ((size_t)b * 4096 + 128 * qb + 32 * rg + crow(r, hi)) * 1024 + h * 256 + 32 * d0 + r32;
                const float val = (o[d0][r] + OM[(d0 * 16 + r) * 64 + lane]) * rl[r] * bf2f(SGC[off]);
                const float vn_ = __shfl_xor(val, 1);
                if ((r32 & 1) == 0) *(unsigned*)(ZC + off) = cvtpk(val, vn_); }
    }
    __syncthreads();
}

__device__ __forceinline__ void sample_scores_unit(const Ptrs& P, int db, int tp, int slot, int lane) {
    const unsigned char* ws = P.ws;
    const _Float16* QI = (const _Float16*)(ws + WS_QI); const _Float16* KI = (const _Float16*)(ws + WS_KI); const float* WI = (const float*)(ws + WS_WI);
    float* SS = (float*)(ws + WS_SS); const float* ckidx = P.in[4]; const int* PT = (const int*)P.in[7];
    const int r32 = lane & 31, hi = lane >> 5, i0 = 2 * tp; const int Rs0 = TP + db * 4 + i0;
    const float NEG = -__builtin_inff();
    const int page = PT[db * 128 + slot];
    h8 qa[4];
    { const int tok = Rs0 + ((lane >> 2) & 1), head = (lane & 3) + 4 * (r32 >> 3);
      const _Float16* qp = QI + ((size_t)tok * 1024 + head * 64 + 8 * hi);
#pragma unroll
      for (int s = 0; s < 4; ++s) qa[s] = *(const h8*)(qp + 16 * s); }
    float w[16];
    { const float* wp = WI + (size_t)(Rs0 + hi) * 16;
#pragma unroll
      for (int k = 0; k < 4; ++k) { const f32x4 t = *(const f32x4*)(wp + 4 * k); w[4 * k] = t[0]; w[4 * k + 1] = t[1]; w[4 * k + 2] = t[2]; w[4 * k + 3] = t[3]; } }
    float* ssrow = SS + (size_t)(db * 4 + i0 + hi) * SS_LD;
#pragma unroll 1
    for (int tp2 = 0; tp2 < 2; ++tp2) {
        f32x4 raw[2][8];
#pragma unroll
        for (int u = 0; u < 2; ++u) { const float* src = ckidx + ((size_t)page * 128 + 32 * (2 * tp2 + u) + r32) * 64 + 8 * hi;
#pragma unroll
            for (int s = 0; s < 4; ++s) { raw[u][2 * s] = *(const f32x4*)(src + 16 * s); raw[u][2 * s + 1] = *(const f32x4*)(src + 16 * s + 4); } }
#pragma unroll
        for (int u = 0; u < 2; ++u) { f32x16 acc = {};
#pragma unroll
            for (int s = 0; s < 4; ++s) { const f32x4 a = raw[u][2 * s], c = raw[u][2 * s + 1];
                const h8 kb = (h8){(_Float16)a[0], (_Float16)a[1], (_Float16)a[2], (_Float16)a[3], (_Float16)c[0], (_Float16)c[1], (_Float16)c[2], (_Float16)c[3]};
                acc = __builtin_amdgcn_mfma_f32_32x32x16_f16(qa[s], kb, acc, 0, 0, 0); }
            float s_ = 0.f;
#pragma unroll
            for (int r = 0; r < 16; ++r) s_ = fmaf(relu_s(acc[r]), w[r], s_);
            ssrow[128 * slot + 32 * (2 * tp2 + u) + r32] = s_; }
    }
    if (slot == 127) {
        const _Float16* src = KI + (size_t)(TP + db * 4 + (r32 < 4 ? r32 : 0)) * 64 + 8 * hi; f32x16 acc = {};
#pragma unroll
        for (int s = 0; s < 4; ++s) acc = __builtin_amdgcn_mfma_f32_32x32x16_f16(qa[s], *(const h8*)(src + 16 * s), acc, 0, 0, 0);
        float s_ = 0.f;
#pragma unroll
        for (int r = 0; r < 16; ++r) s_ = fmaf(relu_s(acc[r]), w[r], s_);
        ssrow[PAST + r32] = (r32 <= i0 + hi) ? s_ : NEG;
    }
}

__device__ __forceinline__ void sample_chunkmix(LAS float* red4, const Ptrs& P, int db, int tid) {
    const unsigned char* ws = P.ws;
    const float* BV = (const float*)(ws + WS_BV); const float* SSQ = (const float*)(ws + WS_SSQ);
    const bf16* BU = (const bf16*)(ws + WS_BU); const bf16* SGB = (const bf16*)(ws + WS_SGB); bf16* ZB = (bf16*)(ws + WS_Z) + Z_STRIDE;
    const float* gsgu = P.in[17]; const float* w_s = P.in[18]; const float* b_s = P.in[19];
    float rs[4];
    { float part = (tid < 64) ? __hip_atomic_load(SSQ + (size_t)(TP + db * 4 + (tid >> 4)) * 16 + (tid & 15), __ATOMIC_RELAXED, __HIP_MEMORY_SCOPE_AGENT) : 0.f;
#pragma unroll
      for (int o = 1; o < 16; o <<= 1) part += __shfl_xor(part, o);
      if (tid < 64 && (tid & 15) == 0) red4[tid >> 4] = part;
      __syncthreads();
#pragma unroll
      for (int q = 0; q < 4; ++q) rs[q] = 1.0f / sqrtf(red4[q] * (1.f / 1024.f) + EPS); }
    for (int c = tid; c < 1024; c += 512) { const int g = c >> 7; float vn[4];
#pragma unroll
        for (int q = 0; q < 4; ++q) { vn[q] = BV[(size_t)(TP + db * 4 + q) * 1024 + c] * rs[q] * gsgu[c]; P.out[O_CVS + (size_t)(db * 4 + q) * 1024 + c] = vn[q]; }
#pragma unroll
        for (int pp = 0; pp < 4; ++pp) { float s = b_s[g * 128 + pp];
#pragma unroll
            for (int q = 0; q < 4; ++q) if (q <= pp) s += w_s[(size_t)(g * 128 + pp) * 128 + q] * vn[q];
            const size_t off = (size_t)(TP + db * 4 + pp) * 1024 + c;
            ZB[off] = (bf16)f2bf(bf2f(BU[off]) * s * bf2f(SGB[off])); } }
}

__device__ __forceinline__ void sample_memattn(LAS unsigned char* lds, const Ptrs& P, int db, int h, int tid, int wid, int lane) {
    const unsigned char* ws = P.ws;
    const bf16* QC = (const bf16*)(ws + WS_QC); const bf16* SGC = (const bf16*)(ws + WS_SGC); bf16* ZC = (bf16*)(ws + WS_Z) + 2 * Z_STRIDE;
    const float* cmk = P.in[5]; const float* cmv = P.in[6];
    LAS float* qf = (LAS float*)lds; LAS float* sc = qf + 1024; LAS float* lsum = sc + 1024; LAS float* pacc = lsum + 16;
    for (int idx = tid; idx < 1024; idx += 512) { const int i = idx >> 8, d = idx & 255; qf[idx] = bf2f(QC[(size_t)(TP + db * 4 + i) * 1024 + h * 256 + d]); }
    __syncthreads();
    { const int m = tid & 255, th = tid >> 8; const float* kr = cmk + ((size_t)(db * 256 + m) * 4 + h) * 256; float d0 = 0.f, d1 = 0.f;
#pragma unroll 1
      for (int dd = 0; dd < 256; dd += 64) { f32x4 kv[16];
#pragma unroll
          for (int u = 0; u < 16; ++u) kv[u] = *(const f32x4*)(kr + dd + 4 * u);
#pragma unroll
          for (int u = 0; u < 16; ++u) { const f32x4 q0 = *(const LAS f32x4*)(qf + (2 * th) * 256 + dd + 4 * u), q1 = *(const LAS f32x4*)(qf + (2 * th + 1) * 256 + dd + 4 * u);
              d0 += (kv[u][0] * q0[0] + kv[u][1] * q0[1]) + (kv[u][2] * q0[2] + kv[u][3] * q0[3]); d1 += (kv[u][0] * q1[0] + kv[u][1] * q1[1]) + (kv[u][2] * q1[2] + kv[u][3] * q1[3]); } }
      sc[(2 * th) * 256 + m] = d0; sc[(2 * th + 1) * 256 + m] = d1; }
    __syncthreads();
    if (wid < 4) { float v[4], mx = -__builtin_inff();
#pragma unroll
        for (int k = 0; k < 4; ++k) { v[k] = sc[wid * 256 + lane + 64 * k]; mx = fmaxf(mx, v[k]); }
        mx = wave_max(mx); float s = 0.f;
#pragma unroll
        for (int k = 0; k < 4; ++k) { v[k] = __builtin_amdgcn_exp2f(v[k] - mx); s += v[k]; sc[wid * 256 + lane + 64 * k] = v[k]; }
        s = wave_sum(s); if (lane == 0) lsum[wid] = s; }
    __syncthreads();
    { const int d = tid & 255, mh = tid >> 8; float a[4] = {0.f, 0.f, 0.f, 0.f};
      const float* vb = cmv + ((size_t)(db * 256 + 128 * mh) * 4 + h) * 256 + d;
#pragma unroll 1
      for (int m0 = 0; m0 < 128; m0 += 16) { float vv[16];
#pragma unroll
          for (int u = 0; u < 16; ++u) vv[u] = vb[(size_t)(m0 + u) * 1024];
#pragma unroll
          for (int u = 0; u < 16; ++u)
#pragma unroll
              for (int i = 0; i < 4; ++i) a[i] += sc[i * 256 + 128 * mh + m0 + u] * vv[u]; }
#pragma unroll
      for (int i = 0; i < 4; ++i) pacc[(mh * 4 + i) * 256 + d] = a[i]; }
    __syncthreads();
    for (int idx = tid; idx < 1024; idx += 512) { const int i = idx >> 8, d = idx & 255; const size_t off = (size_t)(TP + db * 4 + i) * 1024 + h * 256 + d;
        ZC[off] = (bf16)f2bf((pacc[i * 256 + d] + pacc[(4 + i) * 256 + d]) / lsum[i] * bf2f(SGC[off])); }
    __syncthreads();
}

__device__ __forceinline__ void attnA_unit(LAS unsigned char* lds, LAS float* xch, const unsigned char* ws, int b, int g, int j, float M2, int tid, int wid, int lane) {
    const bf16* QB = (const bf16*)(ws + WS_QB); const bf16* KB = (const bf16*)(ws + WS_KB); const bf16* VB = (const bf16*)(ws + WS_VB); const bf16* SGA = (const bf16*)(ws + WS_SGA);
    const unsigned* MASK = (const unsigned*)(ws + WS_MASK); bf16* ZA = (bf16*)(ws + WS_Z);
    const int rg = wid & 3, par = wid >> 2, r32 = lane & 31, hi = lane >> 5;
    const int head = 2 * g + (rg >> 1); const size_t Rq = (size_t)b * 4096 + 64 * j + 32 * (rg & 1) + r32;
    const int nt = j + 1, nit = (nt + 1) >> 1;
    bf16x8 qr[8];
    { const bf16* qp = QB + Rq * 1024 + head * 128 + 8 * hi;
#pragma unroll
      for (int s = 0; s < 8; ++s) qr[s] = *(const bf16x8*)(qp + 16 * s); }
    const unsigned long long* mrow = (const unsigned long long*)(MASK + Rq * 128);
    unsigned long long mw_next = (par < nt) ? mrow[par] : 0ull;
    unsigned voffK[2], voffV[2];
#pragma unroll
    for (int i = 0; i < 2; ++i) { const int pc = 2 * wid + i;
        const int row = 4 * pc + (lane >> 4), chunk = (lane & 15) ^ (row & 7); voffK[i] = (unsigned)(row * 1024 + chunk * 16);
        const int sub = lane >> 5, kk = 8 * (pc >> 1) + ((lane & 31) >> 2), key = (kk & ~0xC) | ((kk & 4) << 1) | ((kk & 8) >> 1), c = 32 * (2 * (pc & 1) + sub) + 8 * (lane & 3);
        voffV[i] = (unsigned)(key * 1024 + c * 2);
        asm volatile("" : "+v"(voffK[i]), "+v"(voffV[i])); }
    const char* Kg = (const char*)(KB + (size_t)b * 4096 * 512 + g * 128); const char* Vg = (const char*)(VB + (size_t)b * 4096 * 512 + g * 128);
#define A_DMA(it_, bf_) do { _Pragma("unroll") for (int tl = 0; tl < 2; ++tl) { const int kt_ = 2 * (it_) + tl; if (kt_ < nt) { \
        const char* kb_ = Kg + (size_t)kt_ * 65536; const char* vb_ = Vg + (size_t)kt_ * 65536; \
        _Pragma("unroll") for (int i = 0; i < 2; ++i) { \
            __builtin_amdgcn_global_load_lds((const unsigned*)(kb_ + voffK[i]), (LAS unsigned*)(lds + (bf_) * 32768 + tl * 16384 + (2 * wid + i) * 1024), 16, 0, 0); \
            __builtin_amdgcn_global_load_lds((const unsigned*)(vb_ + voffV[i]), (LAS unsigned*)(lds + 65536 + (bf_) * 32768 + tl * 16384 + (2 * wid + i) * 1024), 16, 0, 0); } } } } while (0)
    f32x16 o[4];
#pragma unroll
    for (int d0 = 0; d0 < 4; ++d0) o[d0] = f32x16{};
    float l = 0.f;
    A_DMA(0, 0);
    asm volatile("s_waitcnt vmcnt(0)" ::: "memory"); __syncthreads();
    for (int it = 0; it < nit; ++it) {
        const int bf = it & 1; const int kt = 2 * it + par;
        const unsigned long long mw = mw_next;
        mw_next = (kt + 2 < nt) ? mrow[kt + 2] : 0ull;
        if (it + 1 < nit) A_DMA(it + 1, bf ^ 1);
#ifdef DBG_SERIAL_DMA
        asm volatile("s_waitcnt vmcnt(0)" ::: "memory"); __syncthreads();
#endif
        if (kt < nt) {
            const LAS unsigned char* kbase = lds + bf * 32768 + par * 16384; const LAS unsigned char* vp = lds + 65536 + bf * 32768 + par * 16384 + v_rd_base(lane);
            const int mlo = (int)((unsigned)mw >> (4 * hi)), mhi = (int)((unsigned)(mw >> 32) >> (4 * hi));
            f32x16 p0, p1;
#pragma unroll
            for (int r = 0; r < 16; ++r) { p0[r] = -M2; p1[r] = -M2; }
#pragma unroll
            for (int s = 0; s < 8; ++s) { const LAS unsigned char* a = kbase + KSWZ(r32, ((s & 3) * 16 + hi * 8) * 2) + (s >> 2) * 128;
                const bf16x8 b0 = *(const LAS bf16x8*)a, b1 = *(const LAS bf16x8*)(a + 32 * 256);
                p0 = __builtin_amdgcn_mfma_f32_32x32x16_bf16(b0, qr[s], p0, 0, 0, 0);
                p1 = __builtin_amdgcn_mfma_f32_32x32x16_bf16(b1, qr[s], p1, 0, 0, 0); }
#pragma unroll
            for (int r = 0; r < 16; ++r) { const int bit = (r & 3) + 8 * (r >> 2);
                const float e0 = __uint_as_float(__float_as_uint(__builtin_amdgcn_exp2f(p0[r])) & (unsigned)__builtin_amdgcn_sbfe(mlo, bit, 1));
                const float e1 = __uint_as_float(__float_as_uint(__builtin_amdgcn_exp2f(p1[r])) & (unsigned)__builtin_amdgcn_sbfe(mhi, bit, 1));
                p0[r] = e0; p1[r] = e1; l += e0 + e1; }
            bf16x8 pa[4];
            PK4(p0, 0, pa[0]); PK4(p0, 8, pa[1]); PK4(p1, 0, pa[2]); PK4(p1, 8, pa[3]);
            const unsigned vb0 = (unsigned)(uintptr_t)vp;
#define TRRD(dst, off) asm volatile("ds_read_b64_tr_b16 %0, %1 offset:%2" : "=&v"(dst) : "v"(vb0), "i"(off) : "memory")
#define PV_D0(d0) do { s16x4 l0, l1, l2, l3, h0, h1, h2, h3; \
            TRRD(l0, (d0) * 512); TRRD(h0, (d0) * 512 + 2048); TRRD(l1, (d0) * 512 + 4096); TRRD(h1, (d0) * 512 + 6144); \
            TRRD(l2, (d0) * 512 + 8192); TRRD(h2, (d0) * 512 + 10240); TRRD(l3, (d0) * 512 + 12288); TRRD(h3, (d0) * 512 + 14336); \
            asm volatile("s_waitcnt lgkmcnt(0)" ::: "memory"); __builtin_amdgcn_sched_barrier(0); \
            o[d0] = __builtin_amdgcn_mfma_f32_32x32x16_bf16(pa[0], VFRAG(l0, h0), o[d0], 0, 0, 0); \
            o[d0] = __builtin_amdgcn_mfma_f32_32x32x16_bf16(pa[1], VFRAG(l1, h1), o[d0], 0, 0, 0); \
            o[d0] = __builtin_amdgcn_mfma_f32_32x32x16_bf16(pa[2], VFRAG(l2, h2), o[d0], 0, 0, 0); \
            o[d0] = __builtin_amdgcn_mfma_f32_32x32x16_bf16(pa[3], VFRAG(l3, h3), o[d0], 0, 0, 0); } while (0)
            PV_D0(0); PV_D0(1); PV_D0(2); PV_D0(3);
#undef PV_D0
#undef TRRD
        }
        asm volatile("s_waitcnt vmcnt(0)" ::: "memory");
        asm volatile("" : "+v"(mw_next));
        __syncthreads();
    }
#undef A_DMA
    l += __shfl_xor(l, 32);
    LAS float* OM = (LAS float*)lds + rg * 4096; LAS float* LM = xch + rg * 32; LAS float* LM2 = xch + 128 + wid * 32;
    if (par == 1) {
#pragma unroll
        for (int d0 = 0; d0 < 4; ++d0)
#pragma unroll
            for (int r = 0; r < 16; ++r) OM[(d0 * 16 + r) * 64 + lane] = o[d0][r];
        if (hi == 0) LM[r32] = l;
    }
    __syncthreads();
    if (par == 0) {
        l += LM[r32];
        if (hi == 0) LM2[r32] = l;
        float rl[16];
#pragma unroll
        for (int r = 0; r < 16; ++r) rl[r] = 1.0f / LM2[crow(r, hi)];
#pragma unroll
        for (int d0 = 0; d0 < 4; ++d0)
#pragma unroll
            for (int r = 0; r < 16; ++r) { const size_t off = ((size_t)b * 4096 + 64 * j + 32 * (rg & 1) + crow(r, hi)) * 1024 + head * 128 + 32 * d0 + r32;
                const float val = (o[d0][r] + OM[(d0 * 16 + r) * 64 + lane]) * rl[r] * bf2f(SGA[off]);
                const float vn_ = __shfl_xor(val, 1);
                if ((r32 & 1) == 0) *(unsigned*)(ZA + off) = cvtpk(val, vn_); }
    }
    __syncthreads();
}

__device__ __forceinline__ float blk_sum(float v, LAS float* red, int wid, int lane) {
    v = wave_sum(v); if (lane == 0) red[wid] = v; __syncthreads();
    float s = 0.f;
#pragma unroll
    for (int k = 0; k < 8; ++k) s += red[k];
    __syncthreads(); return s;
}
__device__ __forceinline__ float blk_max(float v, LAS float* red, int wid, int lane) {
    v = wave_max(v); if (lane == 0) red[wid] = v; __syncthreads();
    float s = red[0];
#pragma unroll
    for (int k = 1; k < 8; ++k) s = fmaxf(s, red[k]);
    __syncthreads(); return s;
}
__device__ __forceinline__ int blk_isum(int v, LAS int* red, int wid, int lane) {
#pragma unroll
    for (int o = 1; o < 64; o <<= 1) v += __shfl_xor(v, o);
    if (lane == 0) red[wid] = v; __syncthreads();
    int s = 0;
#pragma unroll
    for (int k = 0; k < 8; ++k) s += red[k];
    __syncthreads(); return s;
}
__device__ __forceinline__ int blk_exscan(int v, LAS int* red, int wid, int lane) {
    int inc = v;
#pragma unroll
    for (int o = 1; o < 64; o <<= 1) { const int t = __shfl_up(inc, o); if (lane >= o) inc += t; }
    if (lane == 63) red[wid] = inc; __syncthreads();
    int base = 0;
#pragma unroll
    for (int k = 0; k < 8; ++k) if (k < wid) base += red[k];
    __syncthreads(); return base + inc - v;
}
__device__ __forceinline__ void sample_attn_unit(LAS unsigned char* lds, const Ptrs& P, int qi, int g, int tid, int wid, int lane) {
    const unsigned char* ws = P.ws;
    const float* SS = (const float*)(ws + WS_SS); const bf16* QB = (const bf16*)(ws + WS_QB); const bf16* SGA = (const bf16*)(ws + WS_SGA); bf16* ZA = (bf16*)(ws + WS_Z);
    const float* ck = P.in[2]; const float* cv = P.in[3]; const int* PT = (const int*)P.in[7];
    const int db = qi >> 2, ii = qi & 3; const size_t Rs = TP + qi;
    LAS float* redf = (LAS float*)lds; LAS int* redi = (LAS int*)(lds + 64); LAS int* sel = (LAS int*)(lds + 128);
    LAS float* qf = (LAS float*)(lds + 2048);    LAS float* pl = qf + 256;   LAS float* stat = pl + 512;   LAS float* pacc = stat + 16;
    const float NEG = -__builtin_inff();
    float v[33];
#pragma unroll
    for (int e = 0; e < 33; ++e) { const int key = 33 * tid + e; v[e] = (key < PAST + 4) ? SS[(size_t)qi * SS_LD + key] : NEG; }
    float mn = __builtin_inff(), mx = NEG;
#pragma unroll
    for (int e = 0; e < 33; ++e) { mx = fmaxf(mx, v[e]); mn = fminf(mn, v[e] == NEG ? __builtin_inff() : v[e]); }
    mx = blk_max(mx, redf, wid, lane); mn = -blk_max(-mn, redf, wid, lane);
    float lo = mn - (mx - mn) - 1.0f - fabsf(mn) * 1e-6f, hv = mx, thr = NEG, tv = 0.f; bool tie = false; int X = 0;
    for (int it = 0; it < 256; ++it) {
        const float mid = 0.5f * (lo + hv);
        if (!(mid > lo && mid < hv)) { tie = true; tv = hv; thr = hv; break; }
        int c = 0;
#pragma unroll
        for (int e = 0; e < 33; ++e) c += (v[e] > mid) ? 1 : 0;
        c = blk_isum(c, redi, wid, lane);
        if (c == TOPK) { thr = mid; break; }
        if (c > TOPK) lo = mid; else hv = mid;
    }
    int nsel = 0, ntie = 0;
#pragma unroll
    for (int e = 0; e < 33; ++e) { nsel += (v[e] > thr) ? 1 : 0; ntie += (tie && v[e] == tv) ? 1 : 0; }
    int tquota = 0;
    if (tie) { const int cgt = blk_isum(nsel, redi, wid, lane); const int need = TOPK - cgt; const int before = blk_exscan(ntie, redi, wid, lane);
        tquota = need - before; if (tquota < 0) tquota = 0; if (tquota > ntie) tquota = ntie; }
    (void)X;
    int pos = blk_exscan(nsel + tquota, redi, wid, lane);
    { int tq = tquota;
#pragma unroll
      for (int e = 0; e < 33; ++e) { bool s = v[e] > thr; if (!s && tie && v[e] == tv && tq > 0) { s = true; --tq; }
          if (s) { if (pos < TOPK) sel[pos] = 33 * tid + e; ++pos; } } }
    LAS unsigned long long* rowK = (LAS unsigned long long*)(lds + 8192); LAS unsigned long long* rowV = rowK + 256;
    __syncthreads();
    if (tid < 256) { const int hh = tid >> 7, d = tid & 127; qf[tid] = bf2f(QB[Rs * 1024 + (2 * g + hh) * 128 + d]);
        const int idx = sel[tid];
        const size_t ro = (idx < PAST) ? ((size_t)PT[db * 128 + (idx >> 7)] * 128 + (idx & 127)) * 512 + g * 128 : 0;
        rowK[tid] = (unsigned long long)((idx < PAST) ? ck + ro : P.out + O_KS + (size_t)(db * 4 + (idx - PAST)) * 512 + g * 128);
        rowV[tid] = (unsigned long long)((idx < PAST) ? cv + ro : P.out + O_VS + (size_t)(db * 4 + (idx - PAST)) * 512 + g * 128); }
    __syncthreads();
    { const int k = tid & 255, hh = tid >> 8; const float* kr = (const float*)rowK[k]; float dsum = 0.f;
#pragma unroll 1
      for (int dd = 0; dd < 128; dd += 64) { f32x4 kv[16];
#pragma unroll
          for (int u = 0; u < 16; ++u) kv[u] = *(const f32x4*)(kr + dd + 4 * u);
#pragma unroll
          for (int u = 0; u < 16; ++u) { const f32x4 q = *(const LAS f32x4*)(qf + hh * 128 + dd + 4 * u);
              dsum += (kv[u][0] * q[0] + kv[u][1] * q[1]) + (kv[u][2] * q[2] + kv[u][3] * q[3]); } }
      pl[hh * 256 + k] = dsum; }
    __syncthreads();
    if (wid < 2) { float t[4], m_ = NEG;
#pragma unroll
        for (int k = 0; k < 4; ++k) { t[k] = pl[wid * 256 + lane + 64 * k]; m_ = fmaxf(m_, t[k]); }
        m_ = wave_max(m_); float s = 0.f;
#pragma unroll
        for (int k = 0; k < 4; ++k) { t[k] = __builtin_amdgcn_exp2f(t[k] - m_); s += t[k]; pl[wid * 256 + lane + 64 * k] = t[k]; }
        s = wave_sum(s); if (lane == 0) stat[wid] = s; }
    __syncthreads();
    { const int d = tid & 127, hh = (tid >> 7) & 1, kh = tid >> 8; float a = 0.f;
#pragma unroll 1
      for (int k0 = 128 * kh; k0 < 128 * kh + 128; k0 += 16) { float vv[16];
#pragma unroll
          for (int u = 0; u < 16; ++u) vv[u] = ((const float*)rowV[k0 + u])[d];
#pragma unroll
          for (int u = 0; u < 16; ++u) a += pl[hh * 256 + k0 + u] * vv[u]; }
      pacc[(kh * 2 + hh) * 128 + d] = a; }
    __syncthreads();
    if (tid < 256) { const int hh = tid >> 7, d = tid & 127; const size_t off = Rs * 1024 + (2 * g + hh) * 128 + d;
        ZA[off] = (bf16)f2bf((pacc[hh * 128 + d] + pacc[(2 + hh) * 128 + d]) / stat[hh] * bf2f(SGA[off])); }
    __syncthreads();
}
struct SchedTile {
    int bx, nbr;
    __device__ __forceinline__ bool next(int i, pg8::Unit& u) const {
        if (i >= nbr) return false;
        const int xcd = bx & 7, within = bx >> 3;
        u.pm = i * 33 + xcd * 4 + (within & 3); u.pn = i * 8 + (within >> 2); return true;
    }
    __device__ __forceinline__ void a_ready(const pg8::Unit&) const {}
    __device__ __forceinline__ void done(const pg8::Unit&) const {}
};
__device__ __forceinline__ void unpack8(v4u w, float (&f)[8]) {
    f[0] = __uint_as_float(w.x << 16); f[1] = __uint_as_float(w.x & 0xffff0000u); f[2] = __uint_as_float(w.y << 16); f[3] = __uint_as_float(w.y & 0xffff0000u);
    f[4] = __uint_as_float(w.z << 16); f[5] = __uint_as_float(w.z & 0xffff0000u); f[6] = __uint_as_float(w.w << 16); f[7] = __uint_as_float(w.w & 0xffff0000u);
}
struct EpiMerge {
    static constexpr bool PERM = true, AFTER_DRAIN = false, KEEP_ACC = true;
    unsigned char* ws;
    __device__ __forceinline__ void operator()(pg8::f32x4 (&acc)[2][2][4][2], const pg8::Unit& u, int wr, int wc, int fr, int fq) const {
        asm volatile("" : "+v"(fr), "+v"(fq));
        const int br = u.pn >> 3, pn = u.pn & 7, pm = u.pm - 33 * br;
        const bf16* Rnum = (const bf16*)(ws + WS_R) + (size_t)br * R_STRIDE; const bf16* Rden = Rnum + R_STRIDE; bf16* MB = (bf16*)(ws + WS_MB);
#pragma unroll
        for (int ai = 0; ai < 2; ++ai)
#pragma unroll
            for (int m = 0; m < 4; ++m) { const size_t R = (size_t)(256 * pm + 128 * ai + 64 * wr + 16 * m + fr);
#pragma unroll
                for (int bj = 0; bj < 2; ++bj) { const size_t off = R * 2048 + 256 * pn + 128 * bj + 32 * wc + 8 * fq;
                    float gt[8]; unpack8(*(const v4u*)(Rnum + off), gt);
                    if (br < 2) { float gd[8]; unpack8(*(const v4u*)(Rden + off), gd);
#pragma unroll
                        for (int e = 0; e < 8; ++e) gt[e] *= __builtin_amdgcn_rcpf(gd[e]); }
                    pg8::f32x4 v0 = acc[ai][bj][m][0], v1 = acc[ai][bj][m][1];
#pragma unroll
                    for (int e = 0; e < 4; ++e) { v0[e] *= gt[e]; v1[e] *= gt[4 + e]; }
                    if (br < 2) { acc[ai][bj][m][0] = v0; acc[ai][bj][m][1] = v1; }
                    else *(v4u*)(MB + off) = (v4u){cvtpk(v0[0], v0[1]), cvtpk(v0[2], v0[3]), cvtpk(v1[0], v1[1]), cvtpk(v1[2], v1[3])}; } }
    }
};
struct EpiOut {
    static constexpr bool PERM = true, AFTER_DRAIN = false, KEEP_ACC = false;
    const float* x; float* y;
    __device__ __forceinline__ void operator()(const pg8::f32x4 (&acc)[2][2][4][2], const pg8::Unit& u, int wr, int wc, int fr, int fq) const {
#pragma unroll
        for (int ai = 0; ai < 2; ++ai)
#pragma unroll
            for (int m = 0; m < 4; ++m) { const size_t R = (size_t)(256 * u.pm + 128 * ai + 64 * wr + 16 * m + fr);
#pragma unroll
                for (int bj = 0; bj < 2; ++bj) { const size_t off = R * 2048 + 256 * u.pn + 128 * bj + 32 * wc + 8 * fq;
                    *(pg8::f32x4*)(y + off) = *(const pg8::f32x4*)(x + off) + acc[ai][bj][m][0];
                    *(pg8::f32x4*)(y + off + 4) = *(const pg8::f32x4*)(x + off + 4) + acc[ai][bj][m][1]; } }
    }
};
__device__ __forceinline__ void sample_merge(LAS unsigned char* lds, const unsigned char* ws, int bx, int tid, int wid, int lane) {
    const bf16* Z = (const bf16*)(ws + WS_Z); const bf16* WP = (const bf16*)(ws + WS_WP); const bf16* Rg = (const bf16*)(ws + WS_R); bf16* MB = (bf16*)(ws + WS_MB);
    const int r32 = lane & 31, hi = lane >> 5, n0 = 8 * bx, col = n0 + (r32 & 7);
    f32x16 tot = {};
#pragma unroll
    for (int br = 0; br < 3; ++br) { f32x16 acc = {};
        const bf16* A = Z + (size_t)br * Z_STRIDE + (size_t)(TP + r32) * 1024 + wid * 128 + 8 * hi;
        const bf16* B = WP + ((size_t)br * 2048 + col) * 1024 + wid * 128 + 8 * hi;
#pragma unroll
        for (int s = 0; s < 8; ++s) acc = __builtin_amdgcn_mfma_f32_32x32x16_bf16(*(const bf16x8*)(A + 16 * s), *(const bf16x8*)(B + 16 * s), acc, 0, 0, 0);
#pragma unroll
        for (int r = 0; r < 16; ++r) tot[r] += bf2f(Rg[(size_t)br * R_STRIDE + (size_t)(TP + crow(r, hi)) * 2048 + col]) * acc[r]; }
    LAS float* red = (LAS float*)lds;
#pragma unroll
    for (int r = 0; r < 16; ++r) red[(wid * 16 + r) * 64 + lane] = tot[r];
    __syncthreads();
    if (tid < 256) { const int row = tid >> 3, c = tid & 7; const int h2 = (row >> 2) & 1, r = (row & 3) + 4 * (row >> 3), ln = c + 32 * h2; float s = 0.f;
#pragma unroll
        for (int w = 0; w < 8; ++w) s += red[(w * 16 + r) * 64 + ln];
        MB[(size_t)(TP + row) * 2048 + n0 + c] = (bf16)f2bf(s); }
    __syncthreads();
}
__device__ __forceinline__ void sample_out(LAS unsigned char* lds, const unsigned char* ws, const float* xs, float* ys, int bx, int tid, int wid, int lane) {
    const bf16* MB = (const bf16*)(ws + WS_MB); const bf16* WO = (const bf16*)(ws + WS_WOUT);
    const int r32 = lane & 31, hi = lane >> 5, n0 = 8 * bx, col = n0 + (r32 & 7);
    f32x16 acc = {};
    const bf16* A = MB + (size_t)(TP + r32) * 2048 + wid * 256 + 8 * hi; const bf16* B = WO + (size_t)col * 2048 + wid * 256 + 8 * hi;
#pragma unroll
    for (int s = 0; s < 16; ++s) acc = __builtin_amdgcn_mfma_f32_32x32x16_bf16(*(const bf16x8*)(A + 16 * s), *(const bf16x8*)(B + 16 * s), acc, 0, 0, 0);
    LAS float* red = (LAS float*)lds;
#pragma unroll
    for (int r = 0; r < 16; ++r) red[(wid * 16 + r) * 64 + lane] = acc[r];
    __syncthreads();
    if (tid < 256) { const int row = tid >> 3, c = tid & 7; const int h2 = (row >> 2) & 1, r = (row & 3) + 4 * (row >> 3), ln = c + 32 * h2; float s = 0.f;
#pragma unroll
        for (int w = 0; w < 8; ++w) s += red[(w * 16 + r) * 64 + ln];
        ys[(size_t)row * 2048 + n0 + c] = xs[(size_t)row * 2048 + n0 + c] + s; }
    __syncthreads();
}
#ifndef MK_N_LAUNCHES
#define MK_N_LAUNCHES 1
#endif
constexpr int N_PHASES = 6;
struct Args { const float* in[24]; float* out; unsigned char* ws; int ph_lo, ph_hi; };
__global__ void __launch_bounds__(512, 2) fwd_kernel(Args args) {
    extern __shared__ __attribute__((aligned(16))) unsigned char lds_raw[];
    LAS unsigned char* lds = (LAS unsigned char*)lds_raw;
    volatile LAS unsigned* MISC = (volatile LAS unsigned*)(lds + MISC_OFF);
    LAS float* xch = (LAS float*)(lds + XCH_OFF);
    const int tid = threadIdx.x, lane = tid & 63, wave = __builtin_amdgcn_readfirstlane(tid >> 6);
    const int G = gridDim.x, bx = blockIdx.x; const int vcu = (G % 8 == 0) ? (bx % 8) * (G / 8) + bx / 8 : bx;
    for (int u = tid; u < (LDS_BYTES - LDSCTL_OFF) / 4; u += 512) ((LAS unsigned*)(lds + LDSCTL_OFF))[u] = 0u;
    __syncthreads();
    unsigned char* ws = args.ws;
    gu32* ctl = (gu32*)(ws + WS_CTL);
    XcdBarrier bar; bar.bar = (unsigned*)(ctl + CW_BAR); bar.x = 0; bar.st = nullptr;
    if (MK_N_LAUNCHES == 1) bar = xcd_barrier_post((unsigned*)(ctl + CW_BAR), MISC + 8);
    Ptrs P;
#pragma unroll
    for (int i = 0; i < 24; ++i) P.in[i] = args.in[i];
    P.out = args.out; P.ws = ws;
    const int lo = args.ph_lo, hi_ = args.ph_hi;
#ifdef ONLY_PHASE
#define IN(k) ((k) == ONLY_PHASE && lo <= (k) && (k) < hi_)
#else
#define IN(k) (lo <= (k) && (k) < hi_)
#endif
#define SEAM(k) do { if (IN(k) && IN((k) + 1)) xcd_barrier(bar); } while (0)

#ifndef REP_MASK
#define REP_MASK 0
#endif
#define REPS(k)
    if (IN(0)) { REPS(0) { p0_prologue(P, lds, vcu, G, wave, lane, tid); __syncthreads(); } }
    SEAM(0);
    if (IN(1)) REPS(1) {
        pg8::Gemm g{(const pg8::bf16_t*)(ws + WS_XN), (const pg8::bf16_t*)(ws + WS_WIN), ROWS_A, NB_ALL, 2048};
        SchedIn S{G, bx};
        EpiIn E{P.out, ws, P.in[11], P.in[12], P.in[13], P.in[14], xch};
        pg8::gemm_phase<EpiIn, SchedIn, true, true>(lds, g, S, E);
    }
    SEAM(1);
    if (IN(2)) REPS(2) {
#ifndef P2_PARTS
#define P2_PARTS 63
#endif
        if (P2_PARTS & 1) { const int b = vcu >> 7, pp = vcu & 127;
          indexer_dispatch(lds, ws, b, 255 - pp, wave, lane);
          indexer_dispatch(lds, ws, b, pp, wave, lane); }
        __syncthreads();
        if (P2_PARTS & 2) {
#pragma unroll 1
        for (int k = 0; k < 2; ++k) { const int id = 2 * vcu + k; chunkmix_unit(lds, P, id >> 3, id & 7, tid, wave, lane); } }
        if (P2_PARTS & 4) { const float M2c = logit_bound(P.in[13], P.in[14], 256, lane);
          memattn_unit(lds, xch, P, vcu >> 7, (vcu >> 5) & 3, vcu & 31, M2c, tid, wave, lane); }
        if (P2_PARTS & 8) { const int db = vcu >> 5, ww = (vcu & 31) * 8 + wave; sample_scores_unit(P, db, ww & 1, ww >> 1, lane); }
        if (P2_PARTS & 16) { if (vcu < 8) sample_chunkmix(xch, P, vcu, tid); }
        if (P2_PARTS & 32) { if (vcu >= 32 && vcu < 64) sample_memattn(lds, P, (vcu - 32) >> 2, (vcu - 32) & 3, tid, wave, lane); }
    }
    SEAM(2);
    if (IN(3)) REPS(3) {
        const float M2a = logit_bound(P.in[11], P.in[12], 128, lane);
        const int b = vcu >> 7, g = (vcu >> 5) & 3, jp = vcu & 31;
#ifndef P3_PARTS
#define P3_PARTS 3
#endif
        if (P3_PARTS & 1) {
#pragma unroll 1
        for (int k = 0; k < 2; ++k) attnA_unit(lds, xch, ws, b, g, k == 0 ? 63 - jp : jp, M2a, tid, wave, lane); }
        if (P3_PARTS & 2) { if (vcu < 128) sample_attn_unit(lds, P, vcu >> 2, vcu & 3, tid, wave, lane); }
    }
    SEAM(3);
    if (IN(4)) REPS(4) {
        pg8::Gemm g{(const pg8::bf16_t*)(ws + WS_Z), (const pg8::bf16_t*)(ws + WS_WP), 3 * ROWS_T, 3 * 2048, 1024};
        SchedTile S{bx, 3};
        EpiMerge E{ws};
        pg8::gemm_phase<EpiMerge, SchedTile, true, true>(lds, g, S, E);
        sample_merge(lds, ws, bx, tid, wave, lane);
    }
    SEAM(4);
    if (IN(5)) REPS(5) {
        pg8::Gemm g{(const pg8::bf16_t*)(ws + WS_MB), (const pg8::bf16_t*)(ws + WS_WOUT), TP, 2048, 2048};
        SchedTile S{bx, 1};
        EpiOut E{P.in[0], P.out + O_YP};
        pg8::gemm_phase<EpiOut, SchedTile, true, true>(lds, g, S, E);
        sample_out(lds, ws, P.in[1], P.out + O_YS, bx, tid, wave, lane);
    }
#undef IN
#undef SEAM
}

extern "C" void kernel_launch(void* const* d_in, const int* in_sizes, int n_in, void* d_out, int out_size, void* d_ws, size_t ws_size, hipStream_t stream) {
    static int grid = 0;
    if (grid == 0) {
        if (n_in != 24 || (size_t)out_size != O_TOTAL || ws_size < WS_END) { fprintf(stderr, "kernel_launch: unexpected shapes: n_in %d out_size %d ws %zu\n", n_in, out_size, ws_size); grid = -1; return; }
        int dev = 0, cus = 0;
        if (hipGetDevice(&dev) != hipSuccess || hipDeviceGetAttribute(&cus, hipDeviceAttributeMultiprocessorCount, dev) != hipSuccess) { grid = -1; return; }
        if (hipFuncSetAttribute((const void*)fwd_kernel, hipFuncAttributeMaxDynamicSharedMemorySize, LDS_BYTES) != hipSuccess) { fprintf(stderr, "kernel_launch: hipFuncSetAttribute failed\n"); grid = -1; return; }
        int per_cu = 0;
        if (hipOccupancyMaxActiveBlocksPerMultiprocessor(&per_cu, (const void*)fwd_kernel, 512, LDS_BYTES) != hipSuccess || per_cu < 1) fprintf(stderr, "kernel_launch: occupancy query says %d\n", per_cu);
        (void)hipGetLastError();
        grid = cus;
        if (grid != 256) fprintf(stderr, "kernel_launch: built for a 256-CU device, got %d\n", grid);
    }
    if (grid < 0) return;
    (void)hipMemsetAsync((char*)d_ws + WS_CTL, 0, CTL_ZERO_BYTES, stream);
    Args a{};
    for (int i = 0; i < 24; ++i) a.in[i] = (const float*)d_in[i];
    a.out = (float*)d_out; a.ws = (unsigned char*)d_ws;
#if MK_N_LAUNCHES == 1
    a.ph_lo = 0; a.ph_hi = N_PHASES;
    hipLaunchKernelGGL(fwd_kernel, dim3(grid), dim3(512), LDS_BYTES, stream, a);
#else
    for (int p = 0; p < N_PHASES; ++p) for (int r = 0; r < 1 + ((REP_MASK >> p) & 1); ++r) { a.ph_lo = p; a.ph_hi = p + 1; hipLaunchKernelGGL(fwd_kernel, dim3(grid), dim3(512), LDS_BYTES, stream, a); }
#endif
}
```
